# Optimizing an MI355X kernel written in HIP

```python
import math
import jax, jax.numpy as jnp
from jax import lax
import numpy as np

D_MODEL = 1024
BATCH = 8
SEQ = 2048
DEPTH = 4
DEC_BATCH = 128
DEC_SEQ = 8
PAST_LEN = 16384
PAGE_SIZE = 128

N_META = 16
N_EVEN = (DEPTH + 1) // 2
N_ODD = DEPTH // 2
S5_WIDTH = D_MODEL // 2
S5_GROUP = 16
S5_GROUPS = S5_WIDTH // S5_GROUP
S5_STATE = 64
RET_HEADS = 4
RET_DK = D_MODEL // 16
RET_DV = 2 * RET_DK
RET_QK = RET_HEADS * RET_DK
RET_WIDTH = RET_HEADS * RET_DV
AB_IN = S5_WIDTH + 2 * RET_QK + 2 * RET_WIDTH
AB_SPLITS = [S5_WIDTH, S5_WIDTH + RET_QK, S5_WIDTH + 2 * RET_QK, S5_WIDTH + 2 * RET_QK + RET_WIDTH]
AB_OUT = S5_WIDTH + RET_WIDTH
GLA_HEADS = 4
GLA_DK = D_MODEL // (2 * GLA_HEADS)
GLA_DV = D_MODEL // GLA_HEADS
GLA_QK = GLA_HEADS * GLA_DK
GLA_V = GLA_HEADS * GLA_DV
GLA_LOWRANK = 16
GLA_TAU = 16.0
GLA_IN = 2 * GLA_QK + 2 * GLA_V + GLA_LOWRANK
GLA_SPLITS = [GLA_QK, 2 * GLA_QK, 2 * GLA_QK + GLA_V, 2 * GLA_QK + 2 * GLA_V]
CHUNK = 16
D_FF = 128 * ((8 * D_MODEL // 3 + 127) // 128)
EPS = 1e-6
ROPE_BASE = 10000.0

kernel_name = 's5_retention_gla_macaron_hybrid'


def rmsnorm(x, g):
    xf = x.astype(jnp.float32)
    y = xf * lax.rsqrt(jnp.mean(xf * xf, axis=-1, keepdims=True) + EPS)
    return (y * g.astype(jnp.float32)).astype(x.dtype)


def swiglu(x, w_gu, w_down):
    gate, up = jnp.split(x @ w_gu, 2, axis=-1)
    return (jax.nn.silu(gate) * up) @ w_down


def rotary(x, pos):
    half = x.shape[-1] // 2
    inv_freq = 1.0 / (ROPE_BASE ** (jnp.arange(half, dtype=jnp.float32) / half))
    ang = pos.astype(jnp.float32)[:, None] * inv_freq[None, :]
    cos = jnp.cos(ang)[None, :, None, :]
    sin = jnp.sin(ang)[None, :, None, :]
    xf = x.astype(jnp.float32)
    x1, x2 = xf[..., :half], xf[..., half:]
    return jnp.concatenate([x1 * cos - x2 * sin, x1 * sin + x2 * cos], axis=-1).astype(x.dtype)


def chunked_gated_linear_attn(q, k, v, log_a, s0):
    f32 = jnp.float32
    bsz, L, H, _ = q.shape
    dv = v.shape[-1]
    pad = (-L) % CHUNK

    def to_chunks(t):
        t = jnp.pad(t.astype(f32), ((0, 0), (0, pad), (0, 0), (0, 0)))
        n = t.shape[1] // CHUNK
        return t.reshape(bsz, n, CHUNK, H, t.shape[-1]).transpose(1, 0, 2, 3, 4)

    qc, kc, vc, lac = to_chunks(q), to_chunks(k), to_chunks(v), to_chunks(log_a)
    causal = jnp.tril(jnp.ones((CHUNK, CHUNK), dtype=bool))[None, :, :, None, None]

    def step(S, inp):
        qi, ki, vi, lai = inp
        b = jnp.cumsum(lai, axis=1)
        o_inter = jnp.einsum('bthk,bhkv->bthv', qi * jnp.exp(b), S)
        diff = jnp.where(causal, b[:, :, None] - b[:, None, :], -jnp.inf)
        scores = jnp.einsum('bthk,bshk,btshk->bhts', qi, ki, jnp.exp(diff))
        o_intra = jnp.einsum('bhts,bshv->bthv', scores, vi)
        b_last = b[:, -1]
        S_new = jnp.exp(b_last)[..., None] * S + jnp.einsum(
            'bshk,bshv->bhkv', ki * jnp.exp(b_last[:, None] - b), vi)
        return S_new, o_inter + o_intra

    s_final, o = lax.scan(step, s0.astype(f32), (qc, kc, vc, lac))
    o = o.transpose(1, 0, 2, 3, 4).reshape(bsz, -1, H, dv)[:, :L]
    return o.astype(v.dtype), s_final


def _complex_affine_combine(e1, e2):
    a1r, a1i, b1r, b1i = e1
    a2r, a2i, b2r, b2i = e2
    return (a2r * a1r - a2i * a1i, a2r * a1i + a2i * a1r,
            a2r * b1r - a2i * b1i + b2r, a2r * b1i + a2i * b1r + b2i)


def s5_mixer(u, h0, a_re, a_im, log_dt, b_re, b_im, c_re, c_im, d_skip, w_glu):
    f32 = jnp.float32
    bsz, L, _ = u.shape
    uf = u.astype(f32).reshape(bsz, L, S5_GROUPS, S5_GROUP)
    ar, ai = a_re.astype(f32), a_im.astype(f32)
    dt = jnp.exp(log_dt.astype(f32))[:, None]
    mag = jnp.exp(dt * ar)
    abar_re, abar_im = mag * jnp.cos(dt * ai), mag * jnp.sin(dt * ai)
    den = ar * ar + ai * ai
    num_re = abar_re - 1.0
    f_re = (num_re * ar + abar_im * ai) / den
    f_im = (abar_im * ar - num_re * ai) / den
    br, bi = b_re.astype(f32), b_im.astype(f32)
    bbar_re = f_re[..., None] * br - f_im[..., None] * bi
    bbar_im = f_re[..., None] * bi + f_im[..., None] * br
    x_re = jnp.einsum('gpn,blgn->blgp', bbar_re, uf)
    x_im = jnp.einsum('gpn,blgn->blgp', bbar_im, uf)
    if h0 is not None:
        h0_re, h0_im = h0[0].astype(f32), h0[1].astype(f32)
        x_re = x_re.at[:, 0].add(abar_re * h0_re - abar_im * h0_im)
        x_im = x_im.at[:, 0].add(abar_re * h0_im + abar_im * h0_re)
    a_seq_re = jnp.broadcast_to(abar_re[None, None], (1, L, S5_GROUPS, S5_STATE))
    a_seq_im = jnp.broadcast_to(abar_im[None, None], (1, L, S5_GROUPS, S5_STATE))
    _, _, h_re, h_im = lax.associative_scan(
        _complex_affine_combine, (a_seq_re, a_seq_im, x_re, x_im), axis=1)
    y = (jnp.einsum('gnp,blgp->blgn', c_re.astype(f32), h_re)
         - jnp.einsum('gnp,blgp->blgn', c_im.astype(f32), h_im))
    y = y.reshape(bsz, L, S5_WIDTH) + d_skip.astype(f32) * u.astype(f32)
    z = jax.nn.gelu(y).astype(u.dtype)
    out = z * jax.nn.sigmoid(z @ w_glu)
    return out, (h_re[:, -1], h_im[:, -1])


def mixer_ab(h, pos, s5_h0, ret_s0, w_in, w_out, a_re, a_im, log_dt, b_re, b_im, c_re, c_im, d_skip, w_glu):
    f32 = jnp.float32
    bsz, L, _ = h.shape
    u, q, k, v, g = jnp.split(h @ w_in, AB_SPLITS, axis=-1)
    s5_out, s5_state = s5_mixer(u, s5_h0, a_re, a_im, log_dt, b_re, b_im, c_re, c_im, d_skip, w_glu)
    q = rotary(q.reshape(bsz, L, RET_HEADS, RET_DK), pos)
    k = rotary(k.reshape(bsz, L, RET_HEADS, RET_DK), pos) * (RET_DK ** -0.5)
    v = v.reshape(bsz, L, RET_HEADS, RET_DV)
    log_gamma = jnp.log(1.0 - 2.0 ** (-5.0 - jnp.arange(RET_HEADS, dtype=f32)))
    log_a = jnp.broadcast_to(log_gamma[None, None, :, None], (bsz, L, RET_HEADS, RET_DK))
    if ret_s0 is None:
        ret_s0 = jnp.zeros((bsz, RET_HEADS, RET_DK, RET_DV), f32)
    o, ret_state = chunked_gated_linear_attn(q, k, v, log_a, ret_s0)
    of = o.astype(f32)
    mu = jnp.mean(of, axis=-1, keepdims=True)
    var = jnp.mean(jnp.square(of - mu), axis=-1, keepdims=True)
    on = ((of - mu) * lax.rsqrt(var + EPS)).reshape(bsz, L, RET_WIDTH).astype(h.dtype)
    ret_out = on * jax.nn.silu(g)
    mixed = jnp.concatenate([s5_out, ret_out], axis=-1) @ w_out
    return mixed, s5_state, ret_state


def mixer_gla(h, gla_s0, w_in, w_alpha2, b_alpha, norm_g, w_out):
    f32 = jnp.float32
    bsz, L, _ = h.shape
    q, k, v, r, lr = jnp.split(h @ w_in, GLA_SPLITS, axis=-1)
    log_a = jax.nn.log_sigmoid((lr @ w_alpha2 + b_alpha).astype(f32)) / GLA_TAU
    log_a = log_a.reshape(bsz, L, GLA_HEADS, GLA_DK)
    q = q.reshape(bsz, L, GLA_HEADS, GLA_DK)
    k = k.reshape(bsz, L, GLA_HEADS, GLA_DK) * (GLA_DK ** -0.5)
    v = v.reshape(bsz, L, GLA_HEADS, GLA_DV)
    if gla_s0 is None:
        gla_s0 = jnp.zeros((bsz, GLA_HEADS, GLA_DK, GLA_DV), f32)
    o, gla_state = chunked_gated_linear_attn(q, k, v, log_a, gla_s0)
    of = o.astype(f32)
    on = of * lax.rsqrt(jnp.mean(of * of, axis=-1, keepdims=True) + EPS) * norm_g.astype(f32)
    on = on.reshape(bsz, L, GLA_V).astype(h.dtype)
    return (on * jax.nn.silu(r)) @ w_out, gla_state


def run_trunk(x, pos, s5_re0, s5_im0, ret0, gla0, w):
    s5_re_new, s5_im_new, ret_new, gla_new = [], [], [], []
    for layer in range(DEPTH):
        x = x + 0.5 * swiglu(rmsnorm(x, w['norm_ffn1'][layer]), w['ffn1_w_gu'][layer], w['ffn1_w_down'][layer])
        h = rmsnorm(x, w['norm_mix'][layer])
        if layer % 2 == 0:
            i = layer // 2
            h0 = None if s5_re0 is None else (s5_re0[i], s5_im0[i])
            r0 = None if ret0 is None else ret0[i]
            mixed, (hr, hi), rs = mixer_ab(
                h, pos, h0, r0, w['ab_w_in'][i], w['ab_w_out'][i], w['s5_a_re'][i], w['s5_a_im'][i],
                w['s5_log_dt'][i], w['s5_b_re'][i], w['s5_b_im'][i], w['s5_c_re'][i], w['s5_c_im'][i],
                w['s5_d'][i], w['s5_w_glu'][i])
            s5_re_new.append(hr)
            s5_im_new.append(hi)
            ret_new.append(rs)
        else:
            i = layer // 2
            g0 = None if gla0 is None else gla0[i]
            mixed, gs = mixer_gla(h, g0, w['gla_w_in'][i], w['gla_w_alpha2'][i], w['gla_b_alpha'][i],
                                  w['gla_norm'][i], w['gla_w_out'][i])
            gla_new.append(gs)
        x = x + mixed
        x = x + 0.5 * swiglu(rmsnorm(x, w['norm_ffn2'][layer]), w['ffn2_w_gu'][layer], w['ffn2_w_down'][layer])
    y = rmsnorm(x, w['norm_final'])
    return y, jnp.stack(s5_re_new), jnp.stack(s5_im_new), jnp.stack(ret_new), jnp.stack(gla_new)


def setup_inputs(seed: int = 0) -> dict:
    key = jax.random.key(seed)
    ks = jax.random.split(key, 40)
    f32 = jnp.float32

    def nrm(k, shape, scale):
        return scale * jax.random.normal(k, shape, f32)

    n_idx = jnp.arange(S5_STATE, dtype=f32)
    a_re = -0.5 + nrm(ks[10], (N_EVEN, S5_GROUPS, S5_STATE), 0.01)
    a_im = math.pi * n_idx[None, None, :] + nrm(ks[11], (N_EVEN, S5_GROUPS, S5_STATE), 0.01)
    log_dt = jax.random.uniform(ks[12], (N_EVEN, S5_GROUPS), f32, math.log(1e-3), math.log(1e-1))
    return {
        'x_prompt': nrm(ks[0], (BATCH, SEQ, D_MODEL), 1.0),
        'x_sample': nrm(ks[1], (DEC_BATCH, DEC_SEQ, D_MODEL), 1.0),
        'state_s5_re': nrm(ks[2], (N_EVEN, DEC_BATCH, S5_GROUPS, S5_STATE), 0.1),
        'state_s5_im': nrm(ks[3], (N_EVEN, DEC_BATCH, S5_GROUPS, S5_STATE), 0.1),
        'state_ret': nrm(ks[4], (N_EVEN, DEC_BATCH, RET_HEADS, RET_DK, RET_DV), 0.5),
        'state_gla': nrm(ks[5], (N_ODD, DEC_BATCH, GLA_HEADS, GLA_DK, GLA_DV), 0.5),
        'meta_tokens': nrm(ks[6], (N_META, D_MODEL), 1.0),
        'norm_ffn1': 1.0 + nrm(ks[7], (DEPTH, D_MODEL), 0.01),
        'norm_mix': 1.0 + nrm(ks[8], (DEPTH, D_MODEL), 0.01),
        'norm_ffn2': 1.0 + nrm(ks[9], (DEPTH, D_MODEL), 0.01),
        'norm_final': 1.0 + nrm(ks[13], (D_MODEL,), 0.01),
        'ffn1_w_gu': nrm(ks[14], (DEPTH, D_MODEL, 2 * D_FF), D_MODEL ** -0.5),
        'ffn1_w_down': nrm(ks[15], (DEPTH, D_FF, D_MODEL), D_FF ** -0.5),
        'ffn2_w_gu': nrm(ks[16], (DEPTH, D_MODEL, 2 * D_FF), D_MODEL ** -0.5),
        'ffn2_w_down': nrm(ks[17], (DEPTH, D_FF, D_MODEL), D_FF ** -0.5),
        'ab_w_in': nrm(ks[18], (N_EVEN, D_MODEL, AB_IN), D_MODEL ** -0.5),
        'ab_w_out': nrm(ks[19], (N_EVEN, AB_OUT, D_MODEL), AB_OUT ** -0.5),
        's5_a_re': a_re,
        's5_a_im': a_im,
        's5_log_dt': log_dt,
        's5_b_re': nrm(ks[20], (N_EVEN, S5_GROUPS, S5_STATE, S5_GROUP), (2 * S5_GROUP) ** -0.5),
        's5_b_im': nrm(ks[21], (N_EVEN, S5_GROUPS, S5_STATE, S5_GROUP), (2 * S5_GROUP) ** -0.5),
        's5_c_re': nrm(ks[22], (N_EVEN, S5_GROUPS, S5_GROUP, S5_STATE), (2 * S5_STATE) ** -0.5),
        's5_c_im': nrm(ks[23], (N_EVEN, S5_GROUPS, S5_GROUP, S5_STATE), (2 * S5_STATE) ** -0.5),
        's5_d': nrm(ks[24], (N_EVEN, S5_WIDTH), 1.0),
        's5_w_glu': nrm(ks[25], (N_EVEN, S5_WIDTH, S5_WIDTH), S5_WIDTH ** -0.5),
        'gla_w_in': nrm(ks[26], (N_ODD, D_MODEL, GLA_IN), D_MODEL ** -0.5),
        'gla_w_alpha2': nrm(ks[27], (N_ODD, GLA_LOWRANK, GLA_QK), GLA_LOWRANK ** -0.5),
        'gla_b_alpha': nrm(ks[28], (N_ODD, GLA_QK), 0.1),
        'gla_norm': 1.0 + nrm(ks[29], (N_ODD, GLA_DV), 0.01),
        'gla_w_out': nrm(ks[30], (N_ODD, GLA_V, D_MODEL), GLA_V ** -0.5),
    }


def reference(x_prompt, x_sample, state_s5_re, state_s5_im, state_ret, state_gla, meta_tokens,
              norm_ffn1, norm_mix, norm_ffn2, norm_final, ffn1_w_gu, ffn1_w_down, ffn2_w_gu, ffn2_w_down,
              ab_w_in, ab_w_out, s5_a_re, s5_a_im, s5_log_dt, s5_b_re, s5_b_im, s5_c_re, s5_c_im, s5_d,
              s5_w_glu, gla_w_in, gla_w_alpha2, gla_b_alpha, gla_norm, gla_w_out):
    w = dict(norm_ffn1=norm_ffn1, norm_mix=norm_mix, norm_ffn2=norm_ffn2, norm_final=norm_final,
             ffn1_w_gu=ffn1_w_gu, ffn1_w_down=ffn1_w_down, ffn2_w_gu=ffn2_w_gu, ffn2_w_down=ffn2_w_down,
             ab_w_in=ab_w_in, ab_w_out=ab_w_out, s5_a_re=s5_a_re, s5_a_im=s5_a_im, s5_log_dt=s5_log_dt,
             s5_b_re=s5_b_re, s5_b_im=s5_b_im, s5_c_re=s5_c_re, s5_c_im=s5_c_im, s5_d=s5_d,
             s5_w_glu=s5_w_glu, gla_w_in=gla_w_in, gla_w_alpha2=gla_w_alpha2, gla_b_alpha=gla_b_alpha,
             gla_norm=gla_norm, gla_w_out=gla_w_out)
    bsz = x_prompt.shape[0]
    meta = jnp.broadcast_to(meta_tokens.astype(x_prompt.dtype)[None], (bsz, N_META, D_MODEL))
    xp = jnp.concatenate([meta, x_prompt], axis=1)
    pos_p = jnp.arange(N_META + x_prompt.shape[1], dtype=jnp.int32)
    yp, p_s5_re, p_s5_im, p_ret, p_gla = run_trunk(xp, pos_p, None, None, None, None, w)
    y_prompt = yp[:, N_META:]
    pos_s = PAST_LEN + jnp.arange(x_sample.shape[1], dtype=jnp.int32)
    y_sample, s_s5_re, s_s5_im, s_ret, s_gla = run_trunk(
        x_sample, pos_s, state_s5_re, state_s5_im, state_ret, state_gla, w)
    return (y_prompt, y_sample, p_s5_re, p_s5_im, p_ret, p_gla, s_s5_re, s_s5_im, s_ret, s_gla)
```

```cpp
#include <hip/hip_runtime.h>
#include <hip/hip_cooperative_groups.h>
#include <cstdio>
#include <cstdint>
namespace cg = cooperative_groups;
#define RESID_LO 0
#define PROBE_MASK 0
__device__ __forceinline__ int ltid() { int t = threadIdx.x; asm volatile("" : "+v"(t)); return t; }
__device__ __forceinline__ int lwg() { int t = blockIdx.x; asm volatile("" : "+s"(t)); return t; }
__device__ __forceinline__ int lgrid() { int t = gridDim.x; asm volatile("" : "+s"(t)); return t; }
namespace pg8 {
#define PG8_LAS __attribute__((address_space(3)))
typedef unsigned short bf16_t;
typedef short bf16x8 __attribute__((ext_vector_type(8)));
typedef float f32x4 __attribute__((ext_vector_type(4)));
typedef unsigned u32x4 __attribute__((ext_vector_type(4)));
constexpr int BM = 256, BK = 64, HALF = 128, HTB = HALF * BK * 2  , STAGE_BYTES = 8 * HTB, NXCD = 8, WGM = 8;

__host__ __device__ __forceinline__ int lds_byte(int r, int c) { const int st = (r >> 4) * 2 + (c >> 5), rr = r & 15, cc = c & 31, ob = rr * 64 + cc * 2; return st * 1024 + (ob ^ (((ob >> 9) & 1) << 5)); }
__host__ __device__ __forceinline__ void stage_rc(int b, int& R, int& C) { const int st = b / 1024, sb = b % 1024, swz = sb ^ (((sb >> 9) & 1) << 5); R = (st >> 1) * 16 + swz / 64; C = (st & 1) * 32 + (swz % 64) / 2; }
__host__ __device__ __forceinline__ int perm32(int rho) { const int n = rho >> 4, i = rho & 15; return 8 * (i >> 2) + 4 * n + (i & 3); }

struct Unit { int pm, pn, kofs; };
struct Gemm { const bf16_t* A; const bf16_t* Bt; int M, N, K, ld; };

struct StaticOrder {
    static constexpr bool SPLIT = false;
    int nM, nN, nwg, G, c;
    __host__ __device__ void init(int M, int N, int G_, int c_) { nM = M / BM; nN = N / BM; nwg = nM * nN; G = G_; c = c_; }
    __host__ __device__ bool next(int i, Unit& u) const {
        const long L = (long)i * G + c; if (L >= nwg) return false;
        int wgid = (int)L; { const int q = nwg / NXCD, r = nwg % NXCD, xcd = wgid % NXCD, off = wgid / NXCD; wgid = (xcd < r ? xcd * (q + 1) : r * (q + 1) + (xcd - r) * q) + off; }
        const int nig = WGM * nN, gid = wgid / nig, fm = gid * WGM, gsz = (nM - fm) < WGM ? (nM - fm) : WGM;
        u.pm = fm + ((wgid % nig) % gsz); u.pn = (wgid % nig) / gsz; u.kofs = 0; return true;
    }
    __device__ __forceinline__ void a_ready(const Unit&) const {}
    __device__ __forceinline__ void done(const Unit&) const {}
};

struct SplitOrder {
    static constexpr bool SPLIT = true;
    int pm0, npm, nN, nks, kslice_bytes, G, c;
    __host__ __device__ bool next(int i, Unit& u) const {
        const long L = (long)i * G + c; if (L >= (long)npm * nN * nks) return false;
        const int l = (int)L; u.kofs = (l % nks) * kslice_bytes; u.pn = (l / nks) % nN; u.pm = pm0 + l / (nks * nN); return true;
    }
    __device__ __forceinline__ void a_ready(const Unit&) const {}
    __device__ __forceinline__ void done(const Unit&) const {}
};
__device__ __forceinline__ unsigned cvt_pk_bf16(float lo, float hi) { unsigned r; asm volatile("v_cvt_pk_bf16_f32 %0, %1, %2" : "=v"(r) : "v"(lo), "v"(hi)); return r; }
typedef float f32x2 __attribute__((ext_vector_type(2)));
typedef unsigned u32x2 __attribute__((ext_vector_type(2)));
__device__ __forceinline__ float row_rs(const float* SS, int row) {
    const f32x4* p = (const f32x4*)(SS + (size_t)row * 16);
    const f32x4 a = p[0], b = p[1], c = p[2], d = p[3];
    const float s = (((a[0] + a[1]) + (a[2] + a[3])) + ((b[0] + b[1]) + (b[2] + b[3]))) + (((c[0] + c[1]) + (c[2] + c[3])) + ((d[0] + d[1]) + (d[2] + d[3])));
    return __builtin_amdgcn_rsqf(s * (1.0f / 1024.0f) + 1e-6f);
}
__device__ __forceinline__ void row_rs8(const float* SS, int row0, int fq, float (&rr)[8]) {
    f32x4 pp[8];
#pragma unroll
    for (int g = 0; g < 8; ++g) pp[g] = *(const f32x4*)(SS + (size_t)(row0 + (g >> 2) * HALF + (g & 3) * 16) * 16 + 4 * fq);
#pragma unroll
    for (int g = 0; g < 8; ++g) {
        float s = (pp[g][0] + pp[g][1]) + (pp[g][2] + pp[g][3]);
        s += __shfl_xor(s, 16); s += __shfl_xor(s, 32);
        rr[g] = __builtin_amdgcn_rsqf(s * (1.0f / 1024.0f) + 1e-6f);
    }
}
__device__ __forceinline__ float silu_f(float x) { return x * __builtin_amdgcn_rcpf(1.0f + __expf(-x)); }
__device__ __forceinline__ float sigm_f(float x) { return __builtin_amdgcn_rcpf(1.0f + __expf(-x)); }
__device__ __forceinline__ float bfu_lo(unsigned w) { return __uint_as_float(w << 16); }
__device__ __forceinline__ float bfu_hi(unsigned w) { return __uint_as_float(w & 0xffff0000u); }

struct EpiGU {
    static constexpr bool PERM = true, AFTER_DRAIN = false;
    bf16_t* H; const float* SS; int ldh;
    __device__ __forceinline__ void operator()(const f32x4 (&acc)[2][2][4][2], const Unit& u, int wr, int wc, int fr, int fq) const {
        const int row0 = u.pm * BM + wr * 64 + fr, col0 = u.pn * 128 + wc * 32 + 8 * fq;
        float rr[8]; row_rs8(SS, row0, fq, rr);
#pragma unroll
        for (int ai = 0; ai < 2; ++ai)
#pragma unroll
            for (int m = 0; m < 4; ++m) {
                const int row = row0 + ai * HALF + m * 16; const float r = rr[ai * 4 + m];
                const f32x4 g0 = acc[ai][0][m][0] * r, g1 = acc[ai][0][m][1] * r, u0 = acc[ai][1][m][0] * r, u1 = acc[ai][1][m][1] * r;
                u32x4 w;
                w.x = cvt_pk_bf16(silu_f(g0[0]) * u0[0], silu_f(g0[1]) * u0[1]); w.y = cvt_pk_bf16(silu_f(g0[2]) * u0[2], silu_f(g0[3]) * u0[3]);
                w.z = cvt_pk_bf16(silu_f(g1[0]) * u1[0], silu_f(g1[1]) * u1[1]); w.w = cvt_pk_bf16(silu_f(g1[2]) * u1[2], silu_f(g1[3]) * u1[3]);
                *(u32x4*)(H + (size_t)row * ldh + col0) = w;
            }
    }
};
struct EpiProj {
    static constexpr bool PERM = true, AFTER_DRAIN = false;
    bf16_t* O; const float* SS; int ldc;
    __device__ __forceinline__ void operator()(const f32x4 (&acc)[2][2][4][2], const Unit& u, int wr, int wc, int fr, int fq) const {
        const int row0 = u.pm * BM + wr * 64 + fr, col0 = u.pn * BM + wc * 32 + 8 * fq;
        float rr[8]; row_rs8(SS, row0, fq, rr);
#pragma unroll
        for (int ai = 0; ai < 2; ++ai)
#pragma unroll
            for (int m = 0; m < 4; ++m) {
                const int row = row0 + ai * HALF + m * 16; const float r = rr[ai * 4 + m];
#pragma unroll
                for (int bj = 0; bj < 2; ++bj) {
                    const f32x4 v0 = acc[ai][bj][m][0] * r, v1 = acc[ai][bj][m][1] * r;
                    u32x4 w; w.x = cvt_pk_bf16(v0[0], v0[1]); w.y = cvt_pk_bf16(v0[2], v0[3]); w.z = cvt_pk_bf16(v1[0], v1[1]); w.w = cvt_pk_bf16(v1[2], v1[3]);
                    *(u32x4*)(O + (size_t)row * ldc + col0 + bj * HALF) = w;
                }
            }
    }
};
template <bool ZERO = false> struct EpiResidT {
    static constexpr bool PERM = true, AFTER_DRAIN = false;
    bf16_t* XL; bf16_t* XB; float* SS;
    __device__ __forceinline__ void operator()(const f32x4 (&acc)[2][2][4][2], const Unit& u, int wr, int wc, int fr, int fq) const {
        const int row0 = u.pm * BM + wr * 64 + fr, col0 = u.pn * BM + wc * 32 + 8 * fq;
        u32x4 xin[2][4];
#pragma unroll
        for (int bj = 0; bj < 2; ++bj) { const size_t o = (size_t)row0 * 1024 + col0 + bj * HALF; xin[0][2 * bj] = *(const u32x4*)(XB + o); xin[0][2 * bj + 1] = RESID_LO ? *(const u32x4*)(XL + o) : (u32x4){0u, 0u, 0u, 0u}; }
#pragma unroll
        for (int gI = 0; gI < 8; ++gI) {
            const int ai = gI >> 2, m = gI & 3, cur = gI & 1, nxt = cur ^ 1;
            const int row = row0 + ai * HALF + m * 16;
            if (gI + 1 < 8) {
                const int rown = row0 + ((gI + 1) >> 2) * HALF + ((gI + 1) & 3) * 16;
#pragma unroll
                for (int bj = 0; bj < 2; ++bj) { const size_t o = (size_t)rown * 1024 + col0 + bj * HALF; xin[nxt][2 * bj] = *(const u32x4*)(XB + o); xin[nxt][2 * bj + 1] = RESID_LO ? *(const u32x4*)(XL + o) : (u32x4){0u, 0u, 0u, 0u}; }
            }
            float ss = 0.f;
#pragma unroll
            for (int bj = 0; bj < 2; ++bj) {
                const size_t o = (size_t)row * 1024 + col0 + bj * HALF;
                const u32x4 h = xin[cur][2 * bj], l = xin[cur][2 * bj + 1];
                f32x4 x0 = {bfu_lo(h.x) + bfu_lo(l.x), bfu_hi(h.x) + bfu_hi(l.x), bfu_lo(h.y) + bfu_lo(l.y), bfu_hi(h.y) + bfu_hi(l.y)};
                f32x4 x1 = {bfu_lo(h.z) + bfu_lo(l.z), bfu_hi(h.z) + bfu_hi(l.z), bfu_lo(h.w) + bfu_lo(l.w), bfu_hi(h.w) + bfu_hi(l.w)};
                if (!ZERO) { x0 = x0 + acc[ai][bj][m][0]; x1 = x1 + acc[ai][bj][m][1]; } else { x0 = x0 + acc[ai][bj][m][0] * 0.f; x1 = x1 + acc[ai][bj][m][1] * 0.f; }
                ss += ((x0[0] * x0[0] + x0[1] * x0[1]) + (x0[2] * x0[2] + x0[3] * x0[3])) + ((x1[0] * x1[0] + x1[1] * x1[1]) + (x1[2] * x1[2] + x1[3] * x1[3]));
                u32x4 wh; wh.x = cvt_pk_bf16(x0[0], x0[1]); wh.y = cvt_pk_bf16(x0[2], x0[3]); wh.z = cvt_pk_bf16(x1[0], x1[1]); wh.w = cvt_pk_bf16(x1[2], x1[3]);
                u32x4 wl;
                wl.x = cvt_pk_bf16(x0[0] - bfu_lo(wh.x), x0[1] - bfu_hi(wh.x)); wl.y = cvt_pk_bf16(x0[2] - bfu_lo(wh.y), x0[3] - bfu_hi(wh.y));
                wl.z = cvt_pk_bf16(x1[0] - bfu_lo(wh.z), x1[1] - bfu_hi(wh.z)); wl.w = cvt_pk_bf16(x1[2] - bfu_lo(wh.w), x1[3] - bfu_hi(wh.w));
                *(u32x4*)(XB + o) = wh; if (RESID_LO) *(u32x4*)(XL + o) = wl;
            }
            ss += __shfl_xor(ss, 16); ss += __shfl_xor(ss, 32);
            if (fq == 0) SS[(size_t)row * 16 + u.pn * 4 + wc] = ss;
        }
    }
};
typedef EpiResidT<false> EpiResid;
struct EpiGlu {
    static constexpr bool PERM = true, AFTER_DRAIN = false;
    const bf16_t* Z; bf16_t* A2;
    __device__ __forceinline__ void operator()(const f32x4 (&acc)[2][2][4][2], const Unit& u, int wr, int wc, int fr, int fq) const {
        const int row0 = u.pm * BM + wr * 64 + fr, col0 = u.pn * BM + wc * 32 + 8 * fq;
#pragma unroll
        for (int ai = 0; ai < 2; ++ai)
#pragma unroll
            for (int m = 0; m < 4; ++m) {
                const int row = row0 + ai * HALF + m * 16;
#pragma unroll
                for (int bj = 0; bj < 2; ++bj) {
                    const u32x4 z = *(const u32x4*)(Z + (size_t)row * 512 + col0 + bj * HALF);
                    const f32x4 v0 = acc[ai][bj][m][0], v1 = acc[ai][bj][m][1];
                    u32x4 w;
                    w.x = cvt_pk_bf16(bfu_lo(z.x) * sigm_f(v0[0]), bfu_hi(z.x) * sigm_f(v0[1])); w.y = cvt_pk_bf16(bfu_lo(z.y) * sigm_f(v0[2]), bfu_hi(z.y) * sigm_f(v0[3]));
                    w.z = cvt_pk_bf16(bfu_lo(z.z) * sigm_f(v1[0]), bfu_hi(z.z) * sigm_f(v1[1])); w.w = cvt_pk_bf16(bfu_lo(z.w) * sigm_f(v1[2]), bfu_hi(z.w) * sigm_f(v1[3]));
                    *(u32x4*)(A2 + (size_t)row * 1024 + col0 + bj * HALF) = w;
                }
            }
    }
};
struct EpiPart {
    static constexpr bool PERM = true, AFTER_DRAIN = false;
    bf16_t* P; int row_base, nrows;
    __device__ __forceinline__ void operator()(const f32x4 (&acc)[2][2][4][2], const Unit& u, int wr, int wc, int fr, int fq) const {
        const int row0 = u.pm * BM + wr * 64 + fr - row_base, col0 = u.pn * BM + wc * 32 + 8 * fq;
        bf16_t* base = P + (size_t)(u.kofs >> 9) * nrows * 1024;
#pragma unroll
        for (int ai = 0; ai < 2; ++ai)
#pragma unroll
            for (int m = 0; m < 4; ++m) {
                const int row = row0 + ai * HALF + m * 16;
#pragma unroll
                for (int bj = 0; bj < 2; ++bj) {
                    const f32x4 v0 = acc[ai][bj][m][0], v1 = acc[ai][bj][m][1];
                    u32x4 w; w.x = cvt_pk_bf16(v0[0], v0[1]); w.y = cvt_pk_bf16(v0[2], v0[3]); w.z = cvt_pk_bf16(v1[0], v1[1]); w.w = cvt_pk_bf16(v1[2], v1[3]);
                    *(u32x4*)(base + (size_t)row * 1024 + col0 + bj * HALF) = w;
                }
            }
    }
};
template <class Epi, class Sched, bool ALIGN_EPI = false, bool SP2 = false>
__device__ __forceinline__ void gemm_phase(PG8_LAS unsigned char* lds, const Gemm g, const Sched& S, const Epi& E) {
    const int tid = ltid(), wid = __builtin_amdgcn_readfirstlane(tid >> 6), lane = tid & 63, wr = wid >> 2, wc = wid & 3, fr = lane & 15, fq = lane >> 4;
    const int K = g.ld, nt = g.K / BK;
    unsigned voffA[2], voffB[2];
#pragma unroll
    for (int i = 0; i < 2; ++i) { int R, C; stage_rc(tid * 16 + i * 8192, R, C); const int Rb = Epi::PERM ? ((R & ~31) + perm32(R & 31)) : R;
        voffA[i] = (unsigned)(R * K + C) * 2u; voffB[i] = (unsigned)(Rb * K + C) * 2u; }
    const size_t kstep = (size_t)(BK * 2);
    const size_t hstep = (size_t)HALF * K * 2;
    const size_t tstep = 2 * hstep;
    const unsigned ldsw = (unsigned)wid * 1024u;
    const int aoff = lds_byte(wr * 64 + fr, fq * 8), boff = lds_byte(wc * 32 + fr, fq * 8);
#define PG8_SA(b, h) (((b) * 2 + (h)) * HTB)
#define PG8_SB(b, h) ((4 + (b) * 2 + (h)) * HTB)
#define PG8_STAGE(bufoff, gbase, voff) do { _Pragma("unroll") for (int _i = 0; _i < 2; ++_i) \
        __builtin_amdgcn_global_load_lds((const unsigned*)((const char*)(gbase) + (voff)[_i]), (PG8_LAS unsigned*)(lds + (bufoff) + ldsw + _i * 8192), 16, 0, 0); } while (0)
#define PG8_LDA(dst, b, h) do { _Pragma("unroll") for (int m = 0; m < 4; ++m) _Pragma("unroll") for (int k = 0; k < 2; ++k) dst[m][k] = *(const PG8_LAS bf16x8*)(lds + PG8_SA(b, h) + aoff + m * 2048 + k * 1024); } while (0)
#define PG8_LDB(dst, b, h) do { _Pragma("unroll") for (int n = 0; n < 2; ++n) _Pragma("unroll") for (int k = 0; k < 2; ++k) dst[n][k] = *(const PG8_LAS bf16x8*)(lds + PG8_SB(b, h) + boff + n * 2048 + k * 1024); } while (0)
#define PG8_MMA(ai, bj, At, Bt) do { __builtin_amdgcn_s_setprio(1); _Pragma("unroll") for (int m = 0; m < 4; ++m) _Pragma("unroll") for (int n = 0; n < 2; ++n) _Pragma("unroll") for (int k = 0; k < 2; ++k) \
        acc[ai][bj][m][n] = __builtin_amdgcn_mfma_f32_16x16x32_bf16(Bt[n][k], At[m][k], acc[ai][bj][m][n], 0, 0, 0); __builtin_amdgcn_s_setprio(0); } while (0)
#define PG8_WAIT_V(n) asm volatile("s_waitcnt vmcnt(" #n ")" ::: "memory")
#define PG8_WAIT_L(n) asm volatile("s_waitcnt lgkmcnt(" #n ")" ::: "memory")
#define PG8_BAR __builtin_amdgcn_s_barrier()
#define PG8_SCHED __builtin_amdgcn_sched_barrier(0)
    Unit cur, nxt; int ui = 0;
    if (!S.next(0, cur)) return;
    f32x4 acc[2][2][4][2];
#pragma unroll
    for (int a = 0; a < 2; ++a)
#pragma unroll
        for (int b = 0; b < 2; ++b)
#pragma unroll
            for (int m = 0; m < 4; ++m)
#pragma unroll
                for (int n = 0; n < 2; ++n) acc[a][b][m][n] = (f32x4){0.f, 0.f, 0.f, 0.f};
    bf16x8 At[4][2], B0[2][2], B1[2][2];
    const char* cA = (const char*)g.A + (size_t)cur.pm * tstep + (Sched::SPLIT ? cur.kofs : 0); const char* cB = (const char*)g.Bt + (size_t)cur.pn * tstep + (Sched::SPLIT ? cur.kofs : 0);
    S.a_ready(cur);
    if constexpr (SP2) {
        PG8_STAGE(PG8_SB(0, 0), cB, voffB); PG8_STAGE(PG8_SB(0, 1), cB + hstep, voffB); PG8_STAGE(PG8_SA(0, 0), cA, voffA); PG8_STAGE(PG8_SA(0, 1), cA + hstep, voffA);
        if (wr == 1) PG8_BAR;
        PG8_WAIT_V(2); PG8_BAR;
        PG8_STAGE(PG8_SB(1, 0), cB + kstep, voffB); PG8_STAGE(PG8_SA(1, 0), cA + kstep, voffA); PG8_STAGE(PG8_SB(1, 1), cB + hstep + kstep, voffB);
        PG8_WAIT_V(6); PG8_BAR;
    } else {
        PG8_STAGE(PG8_SB(0, 0), cB, voffB); PG8_STAGE(PG8_SA(0, 0), cA, voffA); PG8_STAGE(PG8_SB(0, 1), cB + hstep, voffB); PG8_STAGE(PG8_SA(0, 1), cA + hstep, voffA);
        if (wr == 1) PG8_BAR;
        PG8_WAIT_V(4); PG8_BAR;
        PG8_STAGE(PG8_SB(1, 0), cB + kstep, voffB); PG8_STAGE(PG8_SA(1, 0), cA + kstep, voffA); PG8_STAGE(PG8_SB(1, 1), cB + hstep + kstep, voffB);
        PG8_WAIT_V(6); PG8_BAR;
    }
    for (;;) {
        const bool has_next = S.next(ui + 1, nxt);
        const char* nA = has_next ? (const char*)g.A + (size_t)nxt.pm * tstep + (Sched::SPLIT ? nxt.kofs : 0) : cA; const char* nB = has_next ? (const char*)g.Bt + (size_t)nxt.pn * tstep + (Sched::SPLIT ? nxt.kofs : 0) : cB;
        for (int t = 0; t < nt; t += 2) {
            const bool last = (t == nt - 2);
            const char* a1 = cA + (size_t)(t + 1) * kstep;
            const char* a2 = last ? nA : cA + (size_t)(t + 2) * kstep; const char* b2 = last ? nB : cB + (size_t)(t + 2) * kstep;
            const char* a3 = a2 + kstep; const char* b3 = b2 + kstep;
            if (last && has_next) S.a_ready(nxt);
            if constexpr (SP2) {
            PG8_LDB(B0, 0, 0); PG8_LDB(B1, 0, 1); PG8_SCHED; PG8_LDA(At, 0, 0); PG8_STAGE(PG8_SA(1, 1), a1 + hstep, voffA);
            PG8_WAIT_V(8); PG8_WAIT_L(0); PG8_BAR; PG8_MMA(0, 0, At, B0); PG8_MMA(0, 1, At, B1); PG8_BAR; PG8_SCHED;
            PG8_LDA(At, 0, 1); PG8_STAGE(PG8_SB(0, 0), b2, voffB); PG8_STAGE(PG8_SB(0, 1), b2 + hstep, voffB); PG8_STAGE(PG8_SA(0, 0), a2, voffA);
            PG8_WAIT_V(8); PG8_WAIT_L(0); PG8_BAR; PG8_MMA(1, 0, At, B0); PG8_MMA(1, 1, At, B1); PG8_BAR; PG8_SCHED;
            PG8_LDB(B0, 1, 0); PG8_LDB(B1, 1, 1); PG8_SCHED; PG8_LDA(At, 1, 0); PG8_STAGE(PG8_SA(0, 1), a2 + hstep, voffA);
            PG8_WAIT_V(8); PG8_WAIT_L(0); PG8_BAR; PG8_MMA(0, 0, At, B0); PG8_MMA(0, 1, At, B1); PG8_BAR; PG8_SCHED;
            PG8_LDA(At, 1, 1); PG8_STAGE(PG8_SB(1, 0), b3, voffB); PG8_STAGE(PG8_SB(1, 1), b3 + hstep, voffB); PG8_STAGE(PG8_SA(1, 0), a3, voffA);
            PG8_WAIT_V(8); PG8_WAIT_L(0); PG8_BAR; PG8_MMA(1, 0, At, B0); PG8_MMA(1, 1, At, B1); PG8_BAR; PG8_SCHED;
            } else {
            PG8_LDB(B0, 0, 0); PG8_SCHED; PG8_LDA(At, 0, 0); PG8_STAGE(PG8_SA(1, 1), a1 + hstep, voffA);
            PG8_WAIT_L(8); PG8_BAR; PG8_WAIT_L(0); PG8_MMA(0, 0, At, B0); PG8_BAR; PG8_SCHED;
            PG8_LDB(B1, 0, 1); PG8_STAGE(PG8_SB(0, 0), b2, voffB);
            PG8_BAR; PG8_WAIT_L(0); PG8_MMA(0, 1, At, B1); PG8_BAR;
            PG8_LDA(At, 0, 1); PG8_STAGE(PG8_SA(0, 0), a2, voffA);
            PG8_BAR; PG8_WAIT_L(0); PG8_MMA(1, 0, At, B0); PG8_BAR; PG8_SCHED;
            PG8_STAGE(PG8_SB(0, 1), b2 + hstep, voffB);
            PG8_WAIT_V(6); PG8_BAR; PG8_MMA(1, 1, At, B1); PG8_BAR;
            PG8_LDB(B0, 1, 0); PG8_SCHED; PG8_LDA(At, 1, 0); PG8_STAGE(PG8_SA(0, 1), a2 + hstep, voffA);
            PG8_WAIT_L(8); PG8_BAR; PG8_WAIT_L(0); PG8_MMA(0, 0, At, B0); PG8_BAR; PG8_SCHED;
            PG8_LDB(B1, 1, 1); PG8_STAGE(PG8_SB(1, 0), b3, voffB);
            PG8_BAR; PG8_WAIT_L(0); PG8_MMA(0, 1, At, B1); PG8_BAR;
            PG8_LDA(At, 1, 1); PG8_STAGE(PG8_SA(1, 0), a3, voffA);
            PG8_BAR; PG8_WAIT_L(0); PG8_MMA(1, 0, At, B0); PG8_BAR; PG8_SCHED;
            PG8_STAGE(PG8_SB(1, 1), b3 + hstep, voffB);
            PG8_WAIT_V(6); PG8_BAR; PG8_MMA(1, 1, At, B1); PG8_BAR;
            }
        }
        if constexpr (ALIGN_EPI) { if (wr == 0) PG8_BAR; }
        if constexpr (!Epi::AFTER_DRAIN) { E(acc, cur, wr, wc, fr, fq); S.done(cur); }
        if (!has_next) break;
#pragma unroll
        for (int a = 0; a < 2; ++a)
#pragma unroll
            for (int b = 0; b < 2; ++b)
#pragma unroll
                for (int m = 0; m < 4; ++m)
#pragma unroll
                    for (int n = 0; n < 2; ++n) acc[a][b][m][n] = (f32x4){0.f, 0.f, 0.f, 0.f};
        cur = nxt; cA = nA; cB = nB; ++ui;
        if constexpr (ALIGN_EPI) { if (wr == 1) PG8_BAR; }
    }
    PG8_WAIT_V(0);
    if constexpr (!ALIGN_EPI) { if (wr == 0) PG8_BAR; }
    PG8_BAR;
    if constexpr (Epi::AFTER_DRAIN) { E.fused(acc, cur, wr, wc, fr, fq, lds, wid, lane); S.done(cur); }
#undef PG8_SA
#undef PG8_SB
#undef PG8_STAGE
#undef PG8_LDA
#undef PG8_LDB
#undef PG8_MMA
#undef PG8_WAIT_V
#undef PG8_WAIT_L
#undef PG8_BAR
#undef PG8_SCHED
}
}
#define LAS __attribute__((address_space(3)))
#define XB_TMO      128
#define XB_XCNT(j)  (256  + 64 * (j))
#define XB_XSUB(j)  (1280 + 64 * (j))
#define XB_XGEN(j)  (2304 + 64 * (j))
#define XB_TOP      3328
#define XB_TOPGEN   3392
#define XCD_BAR_WORDS 3456
#define XB_SPIN_CAP (1u << 18)

__device__ __forceinline__ unsigned xb_ld(unsigned* p)              { return __hip_atomic_load(p, __ATOMIC_RELAXED, __HIP_MEMORY_SCOPE_AGENT); }
__device__ __forceinline__ unsigned xb_add(unsigned* p, unsigned v) { return __hip_atomic_fetch_add(p, v, __ATOMIC_RELAXED, __HIP_MEMORY_SCOPE_AGENT); }
__device__ __forceinline__ unsigned xb_xcc_id() { return (unsigned)__builtin_amdgcn_s_getreg((3 << 11) | 20) & 0xFu; }
#define XB_SPIN(cond, bar) do { unsigned _sp = 0; while (cond) { __builtin_amdgcn_s_sleep(1); \
    if ((++_sp & 255u) == 0u) { if (xb_ld(&(bar)[XB_TMO])) break; if (_sp > XB_SPIN_CAP) { atomicAdd(&(bar)[XB_TMO], 1u); break; } } } } while (0)

struct XcdBarrier {
    unsigned* bar; unsigned x;
    volatile LAS unsigned* st;
};

__device__ __forceinline__ XcdBarrier xcd_barrier_post(unsigned* bar, volatile LAS unsigned* st) {
    XcdBarrier b; b.bar = bar; b.x = xb_xcc_id(); b.st = st;
    if (threadIdx.x == 0) (void)xb_add(&bar[XB_XCNT(b.x)], 1u);
    return b;
}
__device__ __forceinline__ void xcd_barrier_complete(unsigned* bar, unsigned x, unsigned& nloc, unsigned& nx) {
    const unsigned G = gridDim.x * gridDim.y * gridDim.z;
    unsigned sum, cnt, mine, sp = 0u;
    for (;;) {
        sum = 0u; cnt = 0u; mine = 0u;
#pragma unroll
        for (unsigned j = 0; j < 16; ++j) { const unsigned c = xb_ld(&bar[XB_XCNT(j)]); sum += c; cnt += (c > 0u) ? 1u : 0u; mine = (j == x) ? c : mine; }
        if (sum == G) break;
        __builtin_amdgcn_s_sleep(1);
        if ((++sp & 255u) == 0u) { if (xb_ld(&bar[XB_TMO])) break; if (sp > XB_SPIN_CAP) { atomicAdd(&bar[XB_TMO], 1u); break; } }
    }
    nloc = mine > 0u ? mine : 1u; nx = cnt > 0u ? cnt : 1u;
}

__device__ __forceinline__ void xcd_barrier(const XcdBarrier& b) {
    asm volatile("s_waitcnt vmcnt(0)" ::: "memory");
    __syncthreads();
    if (threadIdx.x == 0) {
        unsigned* bar = b.bar;
        __builtin_amdgcn_s_waitcnt(0);
        unsigned nloc = b.st[0], nx = b.st[1];
        if (nloc == 0u) { xcd_barrier_complete(bar, b.x, nloc, nx); b.st[0] = nloc; b.st[1] = nx; }
        const unsigned old = xb_add(&bar[XB_XSUB(b.x)], 1u);
        const unsigned gen = old / nloc;
        if (old + 1u == (gen + 1u) * nloc) {
            __builtin_amdgcn_fence(__ATOMIC_RELEASE, "agent");
            asm volatile("s_waitcnt vmcnt(0)" ::: "memory");
            const unsigned og = xb_add(&bar[XB_TOP], 1u);
            const unsigned tg = og / nx;
            if (og + 1u == (tg + 1u) * nx) xb_add(&bar[XB_TOPGEN], 1u);
            else XB_SPIN(xb_ld(&bar[XB_TOPGEN]) == tg, bar);
            __builtin_amdgcn_fence(__ATOMIC_ACQUIRE, "agent");
            xb_add(&bar[XB_XGEN(b.x)], 1u);
            asm volatile("s_waitcnt vmcnt(0)" ::: "memory");
        } else {
            XB_SPIN(xb_ld(&bar[XB_XGEN(b.x)]) == gen, bar);
            __builtin_amdgcn_fence(__ATOMIC_ACQUIRE, "agent");
            asm volatile("s_waitcnt vmcnt(0)" ::: "memory");
        }
    }
    __syncthreads();
}
typedef unsigned short bf16_t;
typedef float f32x4 __attribute__((ext_vector_type(4)));
typedef short bf16x8 __attribute__((ext_vector_type(8)));
typedef unsigned u32x4 __attribute__((ext_vector_type(4)));
typedef unsigned u32x2 __attribute__((ext_vector_type(2)));
constexpr int DM = 1024, NB = 8, LP = 2064, NSB = 128, NST = 8, NMETA = 16;
constexpr int MP = NB * LP;
constexpr int MR = MP + NSB * NST;
constexpr int MPAD = 17664;
constexpr int DFF = 2816, NGU = 5632, NAB = 2048, NGLA = 3088, NGLAP = 3328;
constexpr int NWAVES = 8, NTHR = 512;
constexpr int LDS_BYTES = 147456, RING_BYTES = 131072;
constexpr int NPHASE = 42;
constexpr size_t SZ_WGU = (size_t)NGU * DM * 2, SZ_WD = (size_t)DM * DFF * 2, SZ_FFN = 2 * (SZ_WGU + SZ_WD);
constexpr size_t SZ_WINAB = (size_t)NAB * DM * 2, SZ_WGLU = 512 * 512 * 2, SZ_WOUT = (size_t)DM * DM * 2, SZ_AB = SZ_WINAB + SZ_WGLU + SZ_WOUT;
constexpr size_t SZ_WING = (size_t)NGLAP * DM * 2, SZ_G = SZ_WING + SZ_WOUT;
constexpr size_t OFF_W = 1u << 20;
constexpr size_t OFF_WAB = OFF_W + 4 * SZ_FFN, OFF_WG = OFF_WAB + 2 * SZ_AB;
constexpr size_t OFF_X = OFF_WG + 2 * SZ_G;
constexpr size_t OFF_XB = OFF_X + (size_t)MPAD * DM * 4;
constexpr size_t OFF_SS = OFF_XB + (size_t)MPAD * DM * 2;
constexpr size_t OFF_HP = OFF_SS + (size_t)MPAD * 16 * 4;
constexpr size_t OFF_A2 = OFF_HP + (size_t)MPAD * NGLAP * 2;
constexpr size_t OFF_Z = OFF_A2 + (size_t)MPAD * DM * 2;
constexpr size_t OFF_O = OFF_Z + (size_t)MPAD * 512 * 2;
constexpr size_t OFF_ROT = OFF_O + (size_t)MPAD * DM * 2;
constexpr int NROT = 2072;
constexpr size_t OFF_S5T = OFF_ROT + (size_t)NROT * 32 * 2 * 4;
constexpr size_t S5T_STRIDE_F = 32 * 64 * 2 + 32 * 64 * 32;
constexpr size_t OFF_S5E = OFF_S5T + 2 * S5T_STRIDE_F * 4;
constexpr size_t OFF_PART = OFF_S5E + (size_t)8 * 32 * 16 * 128 * 4;
constexpr size_t WS_END = OFF_PART + (size_t)11 * 1280 * 1024 * 4;
static_assert(OFF_X % 256 == 0 && OFF_HP % 256 == 0 && OFF_ROT % 256 == 0 && OFF_S5E % 256 == 0, "ws alignment");
constexpr size_t OUT_YP = 0, OUT_YS = OUT_YP + (size_t)NB * 2048 * DM, OUT_PS5R = OUT_YS + (size_t)NSB * NST * DM, OUT_PS5I = OUT_PS5R + 2 * 8 * 32 * 64,
                 OUT_PRET = OUT_PS5I + 2 * 8 * 32 * 64, OUT_PGLA = OUT_PRET + (size_t)2 * 8 * 4 * 64 * 128, OUT_SS5R = OUT_PGLA + (size_t)2 * 8 * 4 * 128 * 256,
                 OUT_SS5I = OUT_SS5R + (size_t)2 * 128 * 32 * 64, OUT_SRET = OUT_SS5I + (size_t)2 * 128 * 32 * 64, OUT_SGLA = OUT_SRET + (size_t)2 * 128 * 4 * 64 * 128,
                 OUT_END = OUT_SGLA + (size_t)2 * 128 * 4 * 128 * 256;
enum { I_XP = 0, I_XS, I_S5R, I_S5I, I_SRET, I_SGLA, I_META, I_NF1, I_NMIX, I_NF2, I_NFIN, I_F1GU, I_F1D, I_F2GU, I_F2D, I_ABIN, I_ABOUT, I_S5AR, I_S5AI, I_S5DT,
       I_S5BR, I_S5BI, I_S5CR, I_S5CI, I_S5D, I_S5GLU, I_GIN, I_GA2, I_GBA, I_GNORM, I_GOUT, N_IN };

struct Args { const float* in[N_IN]; float* out; unsigned char* ws; int ph_lo, ph_hi; };
typedef const __attribute__((address_space(4))) Args* ArgP;
__device__ __forceinline__ ArgP arg_ptr() { ArgP p = (ArgP)__builtin_amdgcn_kernarg_segment_ptr(); asm volatile("" : "+s"(p)); return p; }

__device__ __forceinline__ float bf2f(bf16_t v) { return __uint_as_float((unsigned)v << 16); }
__device__ __forceinline__ bf16_t f2bf(float f) { const unsigned u = __float_as_uint(f); return (bf16_t)((u + 0x7fffu + ((u >> 16) & 1u)) >> 16); }
__device__ __forceinline__ unsigned pk2(float lo, float hi) { return (unsigned)f2bf(lo) | ((unsigned)f2bf(hi) << 16); }
__device__ __forceinline__ float blo(unsigned w) { return __uint_as_float(w << 16); }
__device__ __forceinline__ float bhi(unsigned w) { return __uint_as_float(w & 0xffff0000u); }
__device__ __forceinline__ float wave_sum(float v) {
#pragma unroll
    for (int o = 1; o < 64; o <<= 1) v += __shfl_xor(v, o);
    return v;
}
__device__ __forceinline__ float silu(float x) { return x / (1.0f + __expf(-x)); }
__device__ __forceinline__ float gelu_tanh(float y) {
    const float v = 0.7978845608028654f * (y + 0.044715f * y * y * y);
    const float th = 1.0f - 2.0f / (__expf(2.0f * v) + 1.0f);
    return 0.5f * y * (1.0f + th);
}
__device__ __forceinline__ float logsig(float x) { return fminf(x, 0.f) - __logf(1.0f + __expf(-fabsf(x))); }
#define LDS_FENCE() asm volatile("s_waitcnt lgkmcnt(0)" ::: "memory")

__device__ __forceinline__ bf16_t* w_gu(unsigned char* ws, int l, int which) { return (bf16_t*)(ws + OFF_W + (size_t)l * SZ_FFN + (size_t)which * (SZ_WGU + SZ_WD)); }
__device__ __forceinline__ bf16_t* w_dn(unsigned char* ws, int l, int which) { return (bf16_t*)(ws + OFF_W + (size_t)l * SZ_FFN + (size_t)which * (SZ_WGU + SZ_WD) + SZ_WGU); }
__device__ __forceinline__ bf16_t* w_abin(unsigned char* ws, int i) { return (bf16_t*)(ws + OFF_WAB + (size_t)i * SZ_AB); }
__device__ __forceinline__ bf16_t* w_glu(unsigned char* ws, int i) { return (bf16_t*)(ws + OFF_WAB + (size_t)i * SZ_AB + SZ_WINAB); }
__device__ __forceinline__ bf16_t* w_about(unsigned char* ws, int i) { return (bf16_t*)(ws + OFF_WAB + (size_t)i * SZ_AB + SZ_WINAB + SZ_WGLU); }
__device__ __forceinline__ bf16_t* w_gin(unsigned char* ws, int i) { return (bf16_t*)(ws + OFF_WG + (size_t)i * SZ_G); }
__device__ __forceinline__ bf16_t* w_gout(unsigned char* ws, int i) { return (bf16_t*)(ws + OFF_WG + (size_t)i * SZ_G + SZ_WING); }

__device__ __forceinline__ void transpose_item(const float* W, int K, int Nsrc, bf16_t* WT, const float* gain, float scale, int mode, float* scr, int item, int nblk, int lane) {
    const int kb = item / nblk, nb = item - kb * nblk, k0 = 64 * kb, n0 = 64 * nb;
    int sc0;
    if (mode == 1) { const int t = n0 >> 8, w = n0 & 255; sc0 = (w < 128) ? (t * 128 + w) : (DFF + t * 128 + (w - 128)); }
    else sc0 = n0;
    const int c4 = lane & 15, kq = lane >> 4;
    const bool valid = (sc0 + 4 * c4) < Nsrc;
    f32x4 v[16];
#pragma unroll
    for (int i = 0; i < 16; ++i) {
        const int kk = kq + 4 * i;
        v[i] = valid ? __builtin_nontemporal_load((const f32x4*)(W + (size_t)(k0 + kk) * Nsrc + sc0 + 4 * c4)) : (f32x4){0.f, 0.f, 0.f, 0.f};
    }
#pragma unroll
    for (int i = 0; i < 16; ++i) {
        const int kk = kq + 4 * i; const float g = gain ? gain[k0 + kk] * scale : scale;
        float* d = scr + kk * 65 + 4 * c4;
        d[0] = v[i][0] * g; d[1] = v[i][1] * g; d[2] = v[i][2] * g; d[3] = v[i][3] * g;
    }
    LDS_FENCE();
    const int c = lane & 7;
#pragma unroll
    for (int j = 0; j < 8; ++j) {
        const int n = (lane >> 3) + 8 * j; const float* s = scr + (8 * c) * 65 + n;
        u32x4 o; o.x = pk2(s[0 * 65], s[1 * 65]); o.y = pk2(s[2 * 65], s[3 * 65]); o.z = pk2(s[4 * 65], s[5 * 65]); o.w = pk2(s[6 * 65], s[7 * 65]);
        *(u32x4*)(WT + (size_t)(n0 + n) * K + k0 + 8 * c) = o;
    }
    LDS_FENCE();
}

__device__ __forceinline__ void phase_prologue(ArgP a, unsigned char* smem, int wg, int G) {
    const int tid = ltid(), lane = tid & 63, wave = tid >> 6;
    const int gw = wg * NWAVES + wave, NGW = G * NWAVES;
    unsigned char* ws = a->ws;
    float* scr = (float*)(smem + wave * 16896);
    for (int mid = 0; mid < 26; ++mid) {
        const float* W; const float* gain = nullptr; bf16_t* WT; int K, Nsrc, Nd, mode = 0; float scale = 1.0f;
        if (mid < 16) {
            const int l = mid >> 2, k = mid & 3;
            if (k == 0)      { W = a->in[I_F1GU] + (size_t)l * DM * NGU; K = DM; Nsrc = NGU; Nd = NGU; gain = a->in[I_NF1] + l * DM; mode = 1; WT = w_gu(ws, l, 0); }
            else if (k == 1) { W = a->in[I_F1D] + (size_t)l * DFF * DM; K = DFF; Nsrc = DM; Nd = DM; scale = 0.5f; WT = w_dn(ws, l, 0); }
            else if (k == 2) { W = a->in[I_F2GU] + (size_t)l * DM * NGU; K = DM; Nsrc = NGU; Nd = NGU; gain = a->in[I_NF2] + l * DM; mode = 1; WT = w_gu(ws, l, 1); }
            else             { W = a->in[I_F2D] + (size_t)l * DFF * DM; K = DFF; Nsrc = DM; Nd = DM; scale = 0.5f; WT = w_dn(ws, l, 1); }
        } else if (mid < 22) {
            const int i = (mid - 16) / 3, k = (mid - 16) % 3;
            if (k == 0)      { W = a->in[I_ABIN] + (size_t)i * DM * NAB; K = DM; Nsrc = NAB; Nd = NAB; gain = a->in[I_NMIX] + (2 * i) * DM; WT = w_abin(ws, i); }
            else if (k == 1) { W = a->in[I_S5GLU] + (size_t)i * 512 * 512; K = 512; Nsrc = 512; Nd = 512; WT = w_glu(ws, i); }
            else             { W = a->in[I_ABOUT] + (size_t)i * DM * DM; K = DM; Nsrc = DM; Nd = DM; WT = w_about(ws, i); }
        } else {
            const int i = (mid - 22) >> 1, k = (mid - 22) & 1;
            if (k == 0)      { W = a->in[I_GIN] + (size_t)i * DM * NGLA; K = DM; Nsrc = NGLA; Nd = NGLAP; gain = a->in[I_NMIX] + (2 * i + 1) * DM; WT = w_gin(ws, i); }
            else             { W = a->in[I_GOUT] + (size_t)i * DM * DM; K = DM; Nsrc = DM; Nd = DM; WT = w_gout(ws, i); }
        }
        const int nblk = Nd / 64, nitems = (K / 64) * nblk;
        int start = gw - (mid * 601) % NGW; if (start < 0) start += NGW;
        for (int it = start; it < nitems; it += NGW) transpose_item(W, K, Nsrc, WT, gain, scale, mode, scr, it, nblk, lane);
    }
    bf16_t* __restrict__ XL = (bf16_t*)(ws + OFF_X); bf16_t* __restrict__ XB = (bf16_t*)(ws + OFF_XB); float* __restrict__ SS = (float*)(ws + OFF_SS);
#pragma unroll 4
    for (int m = gw; m < MPAD; m += NGW) {
        const float* src = nullptr;
        if (m < MP) { const int b = m / LP, t = m - b * LP; src = (t < NMETA) ? a->in[I_META] + (size_t)t * DM : a->in[I_XP] + ((size_t)b * 2048 + (t - NMETA)) * DM; }
        else if (m < MR) src = a->in[I_XS] + (size_t)(m - MP) * DM;
        float s = 0.f;
#pragma unroll
        for (int j = 0; j < 4; ++j) {
            f32x4 v = {0.f, 0.f, 0.f, 0.f};
            if (src) v = *((const f32x4*)src + 64 * j + lane);
            u32x2 w; w.x = pk2(v[0], v[1]); w.y = pk2(v[2], v[3]);
            u32x2 wl; wl.x = pk2(v[0] - blo(w.x), v[1] - bhi(w.x)); wl.y = pk2(v[2] - blo(w.y), v[3] - bhi(w.y));
            *((u32x2*)(XB + (size_t)m * DM) + 64 * j + lane) = w;
            if (RESID_LO) *((u32x2*)(XL + (size_t)m * DM) + 64 * j + lane) = wl;
            s += (v[0] * v[0] + v[1] * v[1]) + (v[2] * v[2] + v[3] * v[3]);
        }
        s = wave_sum(s);
        if (lane < 16) SS[(size_t)m * 16 + lane] = (lane == 0) ? s : 0.f;
    }
    {
        const int gt = wg * NTHR + tid, NT = G * NTHR;
        unsigned* pA = (unsigned*)(ws + OFF_A2 + (size_t)MR * DM * 2); unsigned* pZ = (unsigned*)(ws + OFF_Z + (size_t)MR * 512 * 2); unsigned* pO = (unsigned*)(ws + OFF_O + (size_t)MR * DM * 2);
        for (int i = gt; i < (MPAD - MR) * DM / 2; i += NT) { pA[i] = 0u; pO[i] = 0u; }
        for (int i = gt; i < (MPAD - MR) * 512 / 2; i += NT) pZ[i] = 0u;
        float* RC = (float*)(ws + OFF_ROT); float* RS = RC + NROT * 32;
        for (int i = gt; i < NROT * 32; i += NT) {
            const int idx = i >> 5, f = i & 31; const int pos = (idx < LP) ? idx : (16384 + idx - LP);
            const float inv = 1.0f / powf(10000.0f, (float)f / 32.0f);
            const float ang = (float)pos * inv;
            RC[i] = cosf(ang); RS[i] = sinf(ang);
        }
        for (int i = gt; i < 2 * 32 * 64; i += NT) {
            const int ev = i >> 11, gp = i & 2047, g = gp >> 6;
            float* Ta = (float*)(ws + OFF_S5T) + (size_t)ev * S5T_STRIDE_F; float* Tb = Ta + 32 * 64 * 2;
            const float ar = a->in[I_S5AR][i], ai = a->in[I_S5AI][i];
            const float dt = expf(a->in[I_S5DT][ev * 32 + g]);
            const float mag = expf(dt * ar);
            const float abr = mag * cosf(dt * ai), abi = mag * sinf(dt * ai);
            const float den = ar * ar + ai * ai, nre = abr - 1.0f;
            const float fre = (nre * ar + abi * ai) / den, fim = (abi * ar - nre * ai) / den;
            Ta[gp * 2] = abr; Ta[gp * 2 + 1] = abi;
            const float* br = a->in[I_S5BR] + (size_t)i * 16; const float* bi = a->in[I_S5BI] + (size_t)i * 16;
#pragma unroll
            for (int n = 0; n < 16; ++n) { Tb[gp * 32 + n] = fre * br[n] - fim * bi[n]; Tb[gp * 32 + 16 + n] = fre * bi[n] + fim * br[n]; }
        }
    }
}

typedef float f32x2 __attribute__((ext_vector_type(2)));
#define S5_STEP(t)                                                                                                            \
    { const f32x4 ua = *(const f32x4*)(Us + 16 * (t)), ub = *(const f32x4*)(Us + 16 * (t) + 4), uc = *(const f32x4*)(Us + 16 * (t) + 8), ud = *(const f32x4*)(Us + 16 * (t) + 12); \
      f32x2 xa = Bp[0] * ua[0], xb = Bp[4] * ub[0], xc = Bp[8] * uc[0], xd = Bp[12] * ud[0];       \
      xa = Bp[1] * ua[1] + xa; xb = Bp[5] * ub[1] + xb; xc = Bp[9] * uc[1] + xc; xd = Bp[13] * ud[1] + xd;                       \
      xa = Bp[2] * ua[2] + xa; xb = Bp[6] * ub[2] + xb; xc = Bp[10] * uc[2] + xc; xd = Bp[14] * ud[2] + xd;                      \
      xa = Bp[3] * ua[3] + xa; xb = Bp[7] * ub[3] + xb; xc = Bp[11] * uc[3] + xc; xd = Bp[15] * ud[3] + xd;                      \
      const f32x2 x2 = (xa + xb) + (xc + xd);                                                                                   \
                                         \
      const f32x2 hs = {-h2[1], h2[0]};                                                                                         \
      h2 = ab2[0] * h2 + (ab2[1] * hs + x2); }
constexpr int S5_WAVE_LDS = 16 * 136 * 2 + 16 * 16 * 4;

__device__ __forceinline__ void s5_pass1(ArgP a, int ev, unsigned char* smem, int gw, int NGW, int lane, int wave) {
    float* Us = (float*)(smem + wave * S5_WAVE_LDS + 16 * 136 * 2);
    unsigned char* ws = a->ws;
    const bf16_t* PROJ = (const bf16_t*)(ws + OFF_HP);
    const float* Ta = (const float*)(ws + OFF_S5T) + (size_t)ev * S5T_STRIDE_F; const float* Tb = Ta + 32 * 64 * 2;
    float* E = (float*)(ws + OFF_S5E);
    for (int item = gw; item < 8 * 32 * 16; item += NGW) {
        const int j = item & 15, g = (item >> 4) & 31, b = item >> 9;
        const float abr = Ta[(g * 64 + lane) * 2], abi = Ta[(g * 64 + lane) * 2 + 1];
        f32x2 Bp[16];
#pragma unroll
        for (int q = 0; q < 4; ++q) { const f32x4 vr = *((const f32x4*)(Tb + (size_t)(g * 64 + lane) * 32) + q), vi = *((const f32x4*)(Tb + (size_t)(g * 64 + lane) * 32) + 4 + q);
            Bp[4 * q] = (f32x2){vr[0], vi[0]}; Bp[4 * q + 1] = (f32x2){vr[1], vi[1]}; Bp[4 * q + 2] = (f32x2){vr[2], vi[2]}; Bp[4 * q + 3] = (f32x2){vr[3], vi[3]}; }
        const f32x2 ab2 = {abr, abi};
        f32x2 h2 = {0.f, 0.f};
        const bf16_t* up = PROJ + (size_t)(b * LP + j * 128) * NAB + 16 * g;
        u32x2 raw = *(const u32x2*)(up + (size_t)(lane >> 2) * NAB + 4 * (lane & 3));
        for (int blk = 0; blk < 8; ++blk) {
            LDS_FENCE();
            *(f32x4*)(Us + 4 * lane) = (f32x4){blo(raw.x), bhi(raw.x), blo(raw.y), bhi(raw.y)};
            LDS_FENCE();
            if (blk + 1 < 8) raw = *(const u32x2*)(up + (size_t)((blk + 1) * 16 + (lane >> 2)) * NAB + 4 * (lane & 3));
#pragma unroll
            for (int t = 0; t < 16; ++t) S5_STEP(t)
        }
        float* e = E + ((size_t)((b * 32 + g) * 16 + j)) * 128;
        e[lane] = h2[0]; e[64 + lane] = h2[1];
    }
}

__device__ __forceinline__ void s5_pass2(ArgP a, int ev, unsigned char* smem, int gw, int NGW, int lane, int wave) {
    unsigned char* ws = a->ws;
    const bf16_t* PROJ = (const bf16_t*)(ws + OFF_HP);
    bf16_t* Z = (bf16_t*)(ws + OFF_Z);
    const float* Ta = (const float*)(ws + OFF_S5T) + (size_t)ev * S5T_STRIDE_F; const float* Tb = Ta + 32 * 64 * 2;
    const float* E = (const float*)(ws + OFF_S5E);
    bf16_t* Hs = (bf16_t*)(smem + wave * S5_WAVE_LDS);
    float* Us = (float*)(smem + wave * S5_WAVE_LDS + 16 * 136 * 2);
    const int fr = lane & 15, fq = lane >> 4;
    constexpr int NPI = 8 * 32 * 17, NSI = 128 * 32;
    for (int item = gw; item < NPI + NSI; item += NGW) {
        int b, g, j, nblk, nvalid; size_t row0; bool prompt = item < NPI;
        if (prompt) { int bg; if (item < 4096) { j = item & 15; bg = item >> 4; } else { j = 16; bg = item - 4096; }
            g = bg & 31; b = bg >> 5; nblk = (j < 16) ? 8 : 1; nvalid = 16; row0 = (size_t)b * LP + j * 128; }
        else { const int it = item - NPI; g = it & 31; b = it >> 5; j = 0; nblk = 1; nvalid = 8; row0 = (size_t)MP + b * 8; }
        const float abr = Ta[(g * 64 + lane) * 2], abi = Ta[(g * 64 + lane) * 2 + 1];
        f32x2 Bp[16];
#pragma unroll
        for (int q = 0; q < 4; ++q) { const f32x4 vr = *((const f32x4*)(Tb + (size_t)(g * 64 + lane) * 32) + q), vi = *((const f32x4*)(Tb + (size_t)(g * 64 + lane) * 32) + 4 + q);
            Bp[4 * q] = (f32x2){vr[0], vi[0]}; Bp[4 * q + 1] = (f32x2){vr[1], vi[1]}; Bp[4 * q + 2] = (f32x2){vr[2], vi[2]}; Bp[4 * q + 3] = (f32x2){vr[3], vi[3]}; }
        const f32x2 ab2 = {abr, abi};
        bf16x8 Cf[4];
        {
            const float* cr = a->in[I_S5CR] + ((size_t)(ev * 32 + g) * 16 + fr) * 64; const float* ci = a->in[I_S5CI] + ((size_t)(ev * 32 + g) * 16 + fr) * 64;
#pragma unroll
            for (int kb = 0; kb < 4; ++kb) {
                const float* p = (kb < 2) ? (cr + 32 * kb + 8 * fq) : (ci + 32 * (kb - 2) + 8 * fq); const float sg = (kb < 2) ? 1.f : -1.f;
                const f32x4 v0 = *(const f32x4*)p, v1 = *(const f32x4*)(p + 4);
                u32x4 w; w.x = pk2(sg * v0[0], sg * v0[1]); w.y = pk2(sg * v0[2], sg * v0[3]); w.z = pk2(sg * v1[0], sg * v1[1]); w.w = pk2(sg * v1[2], sg * v1[3]);
                Cf[kb] = __builtin_bit_cast(bf16x8, w);
            }
        }
        const float dsk = a->in[I_S5D][ev * 512 + 16 * g + fr];
        float hr = 0.f, hi = 0.f;
        if (prompt) {
            float pr = abr, pi = abi;
#pragma unroll
            for (int s = 0; s < 7; ++s) { const float tr = pr * pr - pi * pi, ti = 2.f * pr * pi; pr = tr; pi = ti; }
            const float* e = E + ((size_t)((b * 32 + g) * 16)) * 128;
            float er[16], ei[16];
#pragma unroll
            for (int jj = 0; jj < 16; ++jj) { er[jj] = 0.f; ei[jj] = 0.f; if (jj < j) { er[jj] = e[jj * 128 + lane]; ei[jj] = e[jj * 128 + 64 + lane]; } }
#pragma unroll
            for (int jj = 0; jj < 16; ++jj) if (jj < j) { const float nr = pr * hr - pi * hi + er[jj], ni = pr * hi + pi * hr + ei[jj]; hr = nr; hi = ni; }
        } else {
            hr = a->in[I_S5R][((size_t)(ev * 128 + b) * 32 + g) * 64 + lane]; hi = a->in[I_S5I][((size_t)(ev * 128 + b) * 32 + g) * 64 + lane];
        }
        float fhr = 0.f, fhi = 0.f;
        f32x2 h2 = {hr, hi};
        const int tl = lane >> 2;
        u32x2 raw = {0u, 0u};
        if (tl < nvalid) raw = *(const u32x2*)(PROJ + (row0 + tl) * NAB + 16 * g + 4 * (lane & 3));
        for (int blk = 0; blk < nblk; ++blk) {
            const size_t rb = row0 + blk * 16;
            *(f32x4*)(Us + 4 * lane) = (f32x4){blo(raw.x), bhi(raw.x), blo(raw.y), bhi(raw.y)};
            LDS_FENCE();
            if (blk + 1 < nblk) raw = *(const u32x2*)(PROJ + (rb + 16 + tl) * NAB + 16 * g + 4 * (lane & 3));
#pragma unroll
            for (int t = 0; t < 16; ++t) {
                S5_STEP(t)
                const unsigned hb = pg8::cvt_pk_bf16(h2[0], h2[1]);
                Hs[t * 136 + lane] = (bf16_t)(hb & 0xffffu); Hs[t * 136 + 64 + lane] = (bf16_t)(hb >> 16);
                if (t == 7) { fhr = h2[0]; fhi = h2[1]; }
            }
            LDS_FENCE();
            f32x4 acc = {0.f, 0.f, 0.f, 0.f};
#pragma unroll
            for (int kb = 0; kb < 4; ++kb) {
                const bf16x8 af = *(const bf16x8*)(Hs + fr * 136 + 32 * kb + 8 * fq);
                acc = __builtin_amdgcn_mfma_f32_16x16x32_bf16(af, Cf[kb], acc, 0, 0, 0);
            }
            LDS_FENCE();
#pragma unroll
            for (int e = 0; e < 4; ++e) {
                const int t = 4 * fq + e;
                if (t < nvalid) {
                    const float uv = Us[16 * t + fr];
                    const float y = acc[e] + dsk * uv;
                    Z[(rb + t) * 512 + 16 * g + fr] = f2bf(gelu_tanh(y));
                }
            }
        }
        if (prompt) {
            if (j == 16) { a->out[OUT_PS5R + ((size_t)(ev * 8 + b) * 32 + g) * 64 + lane] = h2[0]; a->out[OUT_PS5I + ((size_t)(ev * 8 + b) * 32 + g) * 64 + lane] = h2[1]; }
        } else {
            a->out[OUT_SS5R + ((size_t)(ev * 128 + b) * 32 + g) * 64 + lane] = fhr; a->out[OUT_SS5I + ((size_t)(ev * 128 + b) * 32 + g) * 64 + lane] = fhi;
        }
    }
}

constexpr int NCH = 33, NPITEM = NB * 4 * NCH;
template <int DK> __device__ __forceinline__ bf16_t* prep_q(unsigned char* ws, int item) { return (bf16_t*)(ws + OFF_A2) + (size_t)item * 64 * DK; }
template <int DK> __device__ __forceinline__ bf16_t* prep_k(unsigned char* ws, int item) { return (bf16_t*)(ws + OFF_A2) + (size_t)NPITEM * 64 * DK + (size_t)item * 64 * DK; }
__device__ __forceinline__ bf16_t* prep_p(unsigned char* ws, int item) { return (bf16_t*)(ws + OFF_PART) + (size_t)item * 64 * 64; }
__device__ __forceinline__ float* prep_a(unsigned char* ws, int item) { return (float*)(ws + OFF_S5E) + (size_t)item * 128; }

template <int DK, bool GLA>
__device__ __forceinline__ void la_prep(ArgP a, int li, unsigned char* smem, int wg, int G) {
    constexpr int C = 64, LDQ = DK + 8, LDT = C + 8, LDP = GLA ? NGLAP : NAB;
    unsigned char* ws = a->ws;
    const bf16_t* PROJ = (const bf16_t*)(ws + OFF_HP);
    bf16_t* Qt = (bf16_t*)smem;
    bf16_t* Kt = Qt + C * LDQ;
    bf16_t* KhT = Kt + C * LDQ;
    bf16_t* Pb = KhT + DK * LDT;
    float* aS = (float*)(Pb + C * LDT);
    float* Bc = aS + DK;
    float* LR = Bc + (GLA ? C * DK : 0);
    const int tid = ltid(), lane = tid & 63, w = tid >> 6, fr = lane & 15, fq = lane >> 4;
    const float* RC = (const float*)(ws + OFF_ROT); const float* RS = RC + NROT * 32;
    for (int item = wg; item < NPITEM; item += G) {
        const int c = item % NCH, h = (item / NCH) & 3, b = item / (NCH * 4);
        const size_t rowc = (size_t)b * LP + 64 * c;
        const int nv = (c < 32) ? 64 : 16;
        __syncthreads();
        if constexpr (GLA) {
            const int grp = tid >> 7, d = tid & 127;
            float wa[16];
#pragma unroll
            for (int n = 0; n < 16; ++n) wa[n] = a->in[I_GA2][((size_t)li * 16 + n) * 512 + h * 128 + d];
            const float bias = a->in[I_GBA][li * 512 + h * 128 + d];
#pragma unroll
            for (int r = 0; r < 2; ++r) { const int e = tid + r * 512, t = e >> 4, n = e & 15; LR[e] = (t < nv) ? bf2f(PROJ[(rowc + t) * LDP + 3072 + n]) : 0.f; }
            float qv[16], kv[16];
#pragma unroll
            for (int tl = 0; tl < 16; ++tl) {
                const int t = 16 * grp + tl; qv[tl] = 0.f; kv[tl] = 0.f;
                if (t < nv) { qv[tl] = bf2f(PROJ[(rowc + t) * LDP + 128 * h + d]); kv[tl] = bf2f(PROJ[(rowc + t) * LDP + 512 + 128 * h + d]) * 0.08838834764831845f; }
            }
            __syncthreads();
            float bl[16];
            {
                float cum = 0.f;
#pragma unroll
                for (int tl = 0; tl < 16; ++tl) {
                    const int t = 16 * grp + tl; float x = bias;
#pragma unroll
                    for (int n = 0; n < 16; ++n) x = fmaf(LR[t * 16 + n], wa[n], x);
                    const float la = (t < nv) ? logsig(x) * (1.0f / 16.0f) : 0.f;
                    cum += la; bl[tl] = cum;
                }
                Bc[grp * DK + d] = cum;
            }
            __syncthreads();
            {
                float off = 0.f, blast = 0.f;
#pragma unroll
                for (int gg = 0; gg < 4; ++gg) { const float v = Bc[gg * DK + d]; blast += v; if (gg < grp) off += v; }
#pragma unroll
                for (int tl = 0; tl < 16; ++tl) {
                    const int t = 16 * grp + tl; const float bb = bl[tl] + off;
                    Qt[t * LDQ + d] = f2bf(qv[tl] * __expf(bb)); Kt[t * LDQ + d] = f2bf(kv[tl] * __expf(-bb)); KhT[d * LDT + t] = f2bf(kv[tl] * __expf(blast - bb));
                }
                if (grp == 0) aS[d] = __expf(blast);
            }
        } else {
            const float lg = logf(1.0f - exp2f(-5.0f - (float)h));
            const int t = tid >> 3, dg = tid & 7; const int pos = 64 * c + t;
            u32x2 ql = {0u, 0u}, qh = {0u, 0u}, kl = {0u, 0u}, kh = {0u, 0u};
            f32x4 cs = {1.f, 1.f, 1.f, 1.f}, sn = {0.f, 0.f, 0.f, 0.f};
            if (t < nv) {
                const bf16_t* pr = PROJ + (rowc + t) * LDP;
                ql = *(const u32x2*)(pr + 512 + 64 * h + 4 * dg); qh = *(const u32x2*)(pr + 512 + 64 * h + 32 + 4 * dg);
                kl = *(const u32x2*)(pr + 768 + 64 * h + 4 * dg); kh = *(const u32x2*)(pr + 768 + 64 * h + 32 + 4 * dg);
                cs = *(const f32x4*)(RC + (size_t)pos * 32 + 4 * dg); sn = *(const f32x4*)(RS + (size_t)pos * 32 + 4 * dg);
            }
            const int te = (t < nv) ? (t + 1) : nv;
            const float bt = (float)te * lg, blast = (float)nv * lg;
            const float eq = __expf(bt), ek = 0.125f * __expf(-bt), ekh = 0.125f * __expf(blast - bt);
            const float q1[4] = {blo(ql.x), bhi(ql.x), blo(ql.y), bhi(ql.y)}, q2[4] = {blo(qh.x), bhi(qh.x), blo(qh.y), bhi(qh.y)};
            const float k1[4] = {blo(kl.x), bhi(kl.x), blo(kl.y), bhi(kl.y)}, k2[4] = {blo(kh.x), bhi(kh.x), blo(kh.y), bhi(kh.y)};
#pragma unroll
            for (int x = 0; x < 4; ++x) {
                const int d = 4 * dg + x;
                const float qa = q1[x] * cs[x] - q2[x] * sn[x], qb = q1[x] * sn[x] + q2[x] * cs[x];
                const float ka = k1[x] * cs[x] - k2[x] * sn[x], kb = k1[x] * sn[x] + k2[x] * cs[x];
                Qt[t * LDQ + d] = f2bf(qa * eq); Qt[t * LDQ + d + 32] = f2bf(qb * eq);
                Kt[t * LDQ + d] = f2bf(ka * ek); Kt[t * LDQ + d + 32] = f2bf(kb * ek);
                KhT[d * LDT + t] = f2bf(ka * ekh); KhT[(d + 32) * LDT + t] = f2bf(kb * ekh);
            }
        }
        __syncthreads();
        {
            const int ptt = w >> 1;
#pragma unroll
            for (int s2 = 0; s2 < 2; ++s2) {
                const int st = 2 * (w & 1) + s2;
                f32x4 p = {0.f, 0.f, 0.f, 0.f};
                if (st <= ptt) {
#pragma unroll
                    for (int kb = 0; kb < DK / 32; ++kb) {
                        const bf16x8 af = *(const bf16x8*)(Qt + (16 * ptt + fr) * LDQ + 32 * kb + 8 * fq);
                        const bf16x8 bfg = *(const bf16x8*)(Kt + (16 * st + fr) * LDQ + 32 * kb + 8 * fq);
                        p = __builtin_amdgcn_mfma_f32_16x16x32_bf16(af, bfg, p, 0, 0, 0);
                    }
                }
#pragma unroll
                for (int e = 0; e < 4; ++e) { const int t = 16 * ptt + 4 * fq + e, s = 16 * st + fr; Pb[t * LDT + s] = (s <= t) ? f2bf(p[e]) : (bf16_t)0; }
            }
        }
        __syncthreads();
        bf16_t* qg = prep_q<DK>(ws, item); bf16_t* kg = prep_k<DK>(ws, item); bf16_t* pg = prep_p(ws, item);
#pragma unroll
        for (int r = 0; r < DK / 64; ++r) {
            const int e = tid + r * 512;
            { const int t = e / (DK / 8), cc = e % (DK / 8); *(u32x4*)(qg + t * DK + 8 * cc) = *(const u32x4*)(Qt + t * LDQ + 8 * cc); }
            { const int d = e >> 3, cc = e & 7; *(u32x4*)(kg + d * 64 + 8 * cc) = *(const u32x4*)(KhT + d * LDT + 8 * cc); }
        }
        { const int t = tid >> 3, cc = tid & 7; *(u32x4*)(pg + t * 64 + 8 * cc) = *(const u32x4*)(Pb + t * LDT + 8 * cc); }
        if constexpr (GLA) { if (tid < DK) prep_a(ws, item)[tid] = aS[tid]; }
    }
}

template <int DK, int DV, int DVS, bool GLA>
__device__ __forceinline__ void la_prompt(ArgP a, int li, unsigned char* smem, int wg, int G) {
    constexpr int C = 64, NSL = DV / DVS, NTM = DVS / 16, NTN = DK / 16, LDQ = DK + 8, LDT = C + 8, LDP = GLA ? NGLAP : NAB, LDO = 4 * DV, NR = DK / 64;
    static_assert(NTM == 1 || NTM == 2, "dv tiles per slice");
    unsigned char* ws = a->ws;
    const bf16_t* PROJ = (const bf16_t*)(ws + OFF_HP);
    bf16_t* OB = (bf16_t*)(ws + OFF_O);
    constexpr int BUF_ELEMS = C * LDQ + DK * LDT + DVS * LDT + C * LDT + DVS * LDQ + 2 * DK;
    static_assert((BUF_ELEMS * 2) % 16 == 0 && 2 * BUF_ELEMS * 2 <= RING_BYTES, "la_prompt LDS");
    const int tid = ltid(), lane = tid & 63, w = tid >> 6, fr = lane & 15, fq = lane >> 4;
    const int tt = (NTM == 2) ? (w >> 1) : (w & 3), dt = (NTM == 2) ? (w & 1) : 0;
    const bool has_o = (NTM == 2) || (w < 4);
    const bool has_v = GLA || (tid < 256);
    const int vt = GLA ? (tid >> 3) : (tid >> 2), vj4 = GLA ? ((tid & 7) * 4) : ((tid & 3) * 4);
    for (int item0 = wg; item0 < NB * 4 * NSL; item0 += G) {
        const int item = (G == NB * 4 * NSL && (G & 7) == 0) ? (item0 & 7) * (G >> 3) + (item0 >> 3) : item0;
        const int sl = item % NSL, h = (item / NSL) & 3, b = item / (NSL * 4);
        const int pit0 = (b * 4 + h) * NCH;
        const float lg = GLA ? 0.f : logf(1.0f - exp2f(-5.0f - (float)h));
        f32x4 sacc[NTM];
#pragma unroll
        for (int m = 0; m < NTM; ++m) sacc[m] = (f32x4){0.f, 0.f, 0.f, 0.f};
        u32x4 rq0[NR], rk0[NR], rp0, rq1[NR], rk1[NR], rp1; u32x2 rv0 = {0u, 0u}, rv1 = {0u, 0u}; float ra0 = 0.f, ra1 = 0.f;
#define LA_PREFETCH(S_, cc_) do { const int c_ = (cc_); const int nv_ = (c_ < 32) ? 64 : 16; const size_t rowc_ = (size_t)b * LP + 64 * c_; \
            const bf16_t* qg = prep_q<DK>(ws, pit0 + c_); const bf16_t* kg = prep_k<DK>(ws, pit0 + c_); const bf16_t* pg = prep_p(ws, pit0 + c_); \
            _Pragma("unroll") for (int r = 0; r < NR; ++r) { rq##S_[r] = *(const u32x4*)(qg + (size_t)(tid + r * 512) * 8); rk##S_[r] = *(const u32x4*)(kg + (size_t)(tid + r * 512) * 8); } \
            rp##S_ = *(const u32x4*)(pg + (size_t)tid * 8); \
            if (GLA) { if (tid < DK) ra##S_ = prep_a(ws, pit0 + c_)[tid]; } else ra##S_ = __expf((float)nv_ * lg); \
            rv##S_ = (u32x2){0u, 0u}; if (has_v && vt < nv_) rv##S_ = *(const u32x2*)(PROJ + (rowc_ + vt) * LDP + 1024 + DV * h + DVS * sl + vj4); } while (0)
#define LA_BUF(par_) bf16_t* Qt = (bf16_t*)smem + (par_) * BUF_ELEMS; bf16_t* KhT = Qt + C * LDQ; bf16_t* VT = KhT + DK * LDT; bf16_t* Pb = VT + DVS * LDT; bf16_t* ST = Pb + C * LDT; float* aS = (float*)(ST + DVS * LDQ);
#define LA_STAGE(S_, par_) do { LA_BUF(par_) (void)ST; \
            _Pragma("unroll") for (int r = 0; r < NR; ++r) { const int e = tid + r * 512; \
                { const int t = e / (DK / 8), cc = e % (DK / 8); *(u32x4*)(Qt + t * LDQ + 8 * cc) = rq##S_[r]; } \
                { const int d = e >> 3, cc = e & 7; *(u32x4*)(KhT + d * LDT + 8 * cc) = rk##S_[r]; } } \
            { const int t = tid >> 3, cc = tid & 7; *(u32x4*)(Pb + t * LDT + 8 * cc) = rp##S_; } \
            if (tid < DK) aS[tid] = ra##S_; \
            if (has_v) { VT[(vj4 + 0) * LDT + vt] = (bf16_t)(rv##S_.x & 0xffffu); VT[(vj4 + 1) * LDT + vt] = (bf16_t)(rv##S_.x >> 16); \
                         VT[(vj4 + 2) * LDT + vt] = (bf16_t)(rv##S_.y & 0xffffu); VT[(vj4 + 3) * LDT + vt] = (bf16_t)(rv##S_.y >> 16); } } while (0)
#define LA_CHUNK(S_, c_expr) do { const int c = (c_expr); const size_t rowc = (size_t)b * LP + 64 * c; const int nv = (c < 32) ? 64 : 16; \
            __syncthreads(); \
            if (c + 1 < NCH) LA_STAGE(S_, (c + 1) & 1); \
            if (c + 3 < NCH) LA_PREFETCH(S_, c + 3); \
            LA_BUF(c & 1) \
            if (has_o) { \
                f32x4 o = {0.f, 0.f, 0.f, 0.f}; \
                _Pragma("unroll") for (int kb = 0; kb < DK / 32; ++kb) { \
                    const bf16x8 af = *(const bf16x8*)(Qt + (16 * tt + fr) * LDQ + 32 * kb + 8 * fq); \
                    const bf16x8 bfg = *(const bf16x8*)(ST + (16 * dt + fr) * LDQ + 32 * kb + 8 * fq); \
                    o = __builtin_amdgcn_mfma_f32_16x16x32_bf16(af, bfg, o, 0, 0, 0); } \
                _Pragma("unroll") for (int kb = 0; kb < 2; ++kb) { \
                    const bf16x8 af = *(const bf16x8*)(Pb + (16 * tt + fr) * LDT + 32 * kb + 8 * fq); \
                    const bf16x8 bfg = *(const bf16x8*)(VT + (16 * dt + fr) * LDT + 32 * kb + 8 * fq); \
                    o = __builtin_amdgcn_mfma_f32_16x16x32_bf16(af, bfg, o, 0, 0, 0); } \
                _Pragma("unroll") for (int e = 0; e < 4; ++e) { const int t = 16 * tt + 4 * fq + e; if (t < nv) OB[(rowc + t) * LDO + h * DV + DVS * sl + 16 * dt + fr] = f2bf(o[e]); } \
            } \
            if (w < NTN) { \
                const float av = aS[16 * w + fr]; \
                bf16_t* STn = (bf16_t*)smem + ((c + 1) & 1) * BUF_ELEMS + C * LDQ + DK * LDT + DVS * LDT + C * LDT; \
                _Pragma("unroll") for (int m = 0; m < NTM; ++m) { \
                    f32x4 s_ = sacc[m] * av; \
                    _Pragma("unroll") for (int kb = 0; kb < 2; ++kb) { \
                        const bf16x8 af = *(const bf16x8*)(VT + (16 * m + fr) * LDT + 32 * kb + 8 * fq); \
                        const bf16x8 bfg = *(const bf16x8*)(KhT + (16 * w + fr) * LDT + 32 * kb + 8 * fq); \
                        s_ = __builtin_amdgcn_mfma_f32_16x16x32_bf16(af, bfg, s_, 0, 0, 0); } \
                    sacc[m] = s_; \
                    _Pragma("unroll") for (int e = 0; e < 4; ++e) STn[(16 * m + 4 * fq + e) * LDQ + 16 * w + fr] = f2bf(s_[e]); } \
            } } while (0)
        __syncthreads();
        LA_PREFETCH(0, 0);
        LA_STAGE(0, 0);
        { LA_BUF(0) (void)Qt; (void)KhT; (void)VT; (void)Pb; (void)aS;
          if (w < NTN) {
#pragma unroll
              for (int m = 0; m < NTM; ++m)
#pragma unroll
                  for (int e = 0; e < 4; ++e) ST[(16 * m + 4 * fq + e) * LDQ + 16 * w + fr] = (bf16_t)0;
          } }
        LA_PREFETCH(1, 1);
        LA_PREFETCH(0, 2);
        for (int c2 = 0; c2 < NCH; c2 += 2) {
            LA_CHUNK(1, c2);
            if (c2 + 1 < NCH) LA_CHUNK(0, c2 + 1);
        }
#undef LA_CHUNK
#undef LA_BUF
#undef LA_STAGE
#undef LA_PREFETCH
        if (w < NTN) {
            float* so = a->out + (GLA ? OUT_PGLA : OUT_PRET) + (((size_t)(li * NB + b) * 4 + h) * DK + 16 * w + fr) * DV + DVS * sl;
#pragma unroll
            for (int m = 0; m < NTM; ++m) __builtin_nontemporal_store(sacc[m], (f32x4*)(so + 16 * m + 4 * fq));
        }
    }
}

template <int DK, int DV, bool GLA>
__device__ __forceinline__ void la_sample(ArgP a, int li, unsigned char* smem, int wg, int G) {
    constexpr int NJ4 = DV / 4, NG = NTHR / NJ4, RPG = DK / NG, LDP = GLA ? NGLAP : NAB, LDO = 4 * DV;
    unsigned char* ws = a->ws;
    const bf16_t* PROJ = (const bf16_t*)(ws + OFF_HP);
    bf16_t* OB = (bf16_t*)(ws + OFF_O);
    float* QK = (float*)smem;
    float* Kts = QK + DK * 16;
    float* Qts = Kts + 8 * DK;
    float* As = Qts + 8 * DK;
    float* Vs = As + DK;
    float* Ps = Vs + 8 * DV;
    float* Ored = Ps + 64;
    float* LR = Ored + NG * 8 * DV;
    const int tid = ltid();
    const float* RC = (const float*)(ws + OFF_ROT); const float* RS = RC + NROT * 32;
    const float* S0base = a->in[GLA ? I_SGLA : I_SRET]; float* S1base = a->out + (GLA ? OUT_SGLA : OUT_SRET);
    for (int item = wg; item < NSB * 4; item += G) {
        const int b = item >> 2, h = item & 3;
        const size_t row0 = (size_t)MP + b * 8;
        __syncthreads();
        for (int e = tid; e < 8 * DV; e += NTHR) { const int t = e / DV, j = e % DV; Vs[e] = bf2f(PROJ[(row0 + t) * LDP + 1024 + h * DV + j]); }
        if constexpr (GLA) {
            if (tid < 128) LR[tid] = bf2f(PROJ[(row0 + (tid >> 4)) * LDP + 3072 + (tid & 15)]);
            __syncthreads();
            if (tid < DK) {
                const int d = tid; float bt[8]; float cum = 0.f;
                const float bias = a->in[I_GBA][li * 512 + h * 128 + d];
                float wa[16];
#pragma unroll
                for (int n = 0; n < 16; ++n) wa[n] = a->in[I_GA2][((size_t)li * 16 + n) * 512 + h * 128 + d];
#pragma unroll
                for (int t = 0; t < 8; ++t) {
                    float x = bias;
#pragma unroll
                    for (int n = 0; n < 16; ++n) x = fmaf(LR[t * 16 + n], wa[n], x);
                    cum += logsig(x) * (1.0f / 16.0f); bt[t] = cum;
                }
#pragma unroll
                for (int t = 0; t < 8; ++t) {
                    const float q = bf2f(PROJ[(row0 + t) * LDP + 128 * h + d]);
                    const float k = bf2f(PROJ[(row0 + t) * LDP + 512 + 128 * h + d]) * 0.08838834764831845f;
                    const float qt = q * __expf(bt[t]);
                    QK[d * 16 + t] = qt; QK[d * 16 + 8 + t] = k * __expf(bt[7] - bt[t]); Kts[t * DK + d] = k * __expf(-bt[t]); Qts[t * DK + d] = qt;
                }
                As[d] = __expf(bt[7]);
            }
        } else {
            if (tid < 256) {
                const int t = tid >> 5, d = tid & 31;
                const float lg = logf(1.0f - exp2f(-5.0f - (float)h));
                const bf16_t* pr = PROJ + (row0 + t) * LDP;
                const float q1 = bf2f(pr[512 + 64 * h + d]), q2 = bf2f(pr[512 + 64 * h + 32 + d]), k1 = bf2f(pr[768 + 64 * h + d]), k2 = bf2f(pr[768 + 64 * h + 32 + d]);
                const float cs = RC[(size_t)(LP + t) * 32 + d], sn = RS[(size_t)(LP + t) * 32 + d];
                const float qa = q1 * cs - q2 * sn, qb = q1 * sn + q2 * cs, ka = k1 * cs - k2 * sn, kb = k1 * sn + k2 * cs;
                const float bt = (float)(t + 1) * lg;
                const float eq = __expf(bt), ek = 0.125f * __expf(-bt), ekh = 0.125f * __expf(8.0f * lg - bt);
                QK[d * 16 + t] = qa * eq; QK[(d + 32) * 16 + t] = qb * eq; QK[d * 16 + 8 + t] = ka * ekh; QK[(d + 32) * 16 + 8 + t] = kb * ekh;
                Kts[t * DK + d] = ka * ek; Kts[t * DK + d + 32] = kb * ek; Qts[t * DK + d] = qa * eq; Qts[t * DK + d + 32] = qb * eq;
                if (tid < DK) As[tid] = __expf(8.0f * lg);
            }
        }
        __syncthreads();
        if (tid < 64) {
            const int t = tid >> 3, s = tid & 7; float p = 0.f;
            if (s <= t) { for (int d = 0; d < DK; ++d) p = fmaf(Qts[t * DK + d], Kts[s * DK + d], p); }
            Ps[tid] = p;
        }
        const int grp = tid / NJ4, j4 = (tid % NJ4) * 4;
        const float* S0 = S0base + ((size_t)(li * NSB + b) * 4 + h) * DK * DV; float* S1 = S1base + ((size_t)(li * NSB + b) * 4 + h) * DK * DV;
        f32x4 s0[RPG];
#pragma unroll
        for (int ii = 0; ii < RPG; ++ii) s0[ii] = __builtin_nontemporal_load((const f32x4*)(S0 + (size_t)(grp * RPG + ii) * DV + j4));
        f32x4 vj[8], oa[8];
#pragma unroll
        for (int s2 = 0; s2 < 8; ++s2) { vj[s2] = *(const f32x4*)(Vs + s2 * DV + j4); oa[s2] = (f32x4){0.f, 0.f, 0.f, 0.f}; }
#pragma unroll
        for (int ii = 0; ii < RPG; ++ii) {
            const int i = grp * RPG + ii;
            const f32x4 qa = *(const f32x4*)(QK + i * 16), qb = *(const f32x4*)(QK + i * 16 + 4), ka = *(const f32x4*)(QK + i * 16 + 8), kb = *(const f32x4*)(QK + i * 16 + 12);
            const f32x4 sv = s0[ii];
            oa[0] = sv * qa[0] + oa[0]; oa[1] = sv * qa[1] + oa[1]; oa[2] = sv * qa[2] + oa[2]; oa[3] = sv * qa[3] + oa[3];
            oa[4] = sv * qb[0] + oa[4]; oa[5] = sv * qb[1] + oa[5]; oa[6] = sv * qb[2] + oa[6]; oa[7] = sv * qb[3] + oa[7];
            f32x4 sn = sv * As[i];
            sn = vj[0] * ka[0] + sn; sn = vj[1] * ka[1] + sn; sn = vj[2] * ka[2] + sn; sn = vj[3] * ka[3] + sn;
            sn = vj[4] * kb[0] + sn; sn = vj[5] * kb[1] + sn; sn = vj[6] * kb[2] + sn; sn = vj[7] * kb[3] + sn;
            __builtin_nontemporal_store(sn, (f32x4*)(S1 + (size_t)i * DV + j4));
        }
#pragma unroll
        for (int t = 0; t < 8; ++t) *(f32x4*)(Ored + (grp * 8 + t) * DV + j4) = oa[t];
        __syncthreads();
        for (int e = tid; e < 8 * NJ4; e += NTHR) {
            const int t = e / NJ4, jj = (e % NJ4) * 4; f32x4 o = {0.f, 0.f, 0.f, 0.f};
#pragma unroll
            for (int g2 = 0; g2 < NG; ++g2) o = o + *(const f32x4*)(Ored + (g2 * 8 + t) * DV + jj);
#pragma unroll
            for (int s2 = 0; s2 < 8; ++s2) o = *(const f32x4*)(Vs + s2 * DV + jj) * Ps[t * 8 + s2] + o;
            u32x2 wv; wv.x = pk2(o[0], o[1]); wv.y = pk2(o[2], o[3]);
            *(u32x2*)(OB + (row0 + t) * LDO + h * DV + jj) = wv;
        }
    }
}

__device__ __forceinline__ void ret_finalize(ArgP a, int gw, int NGW, int lane) {
    unsigned char* ws = a->ws;
    const bf16_t* __restrict__ PROJ = (const bf16_t*)(ws + OFF_HP); const bf16_t* __restrict__ OB = (const bf16_t*)(ws + OFF_O); bf16_t* __restrict__ A2 = (bf16_t*)(ws + OFF_A2);
#pragma unroll 4
    for (int m = gw; m < MR; m += NGW) {
        const u32x4 ow = *((const u32x4*)(OB + (size_t)m * 512) + lane);
        const u32x4 gwd = *((const u32x4*)(PROJ + (size_t)m * NAB + 1536) + lane);
        float o[8] = {blo(ow.x), bhi(ow.x), blo(ow.y), bhi(ow.y), blo(ow.z), bhi(ow.z), blo(ow.w), bhi(ow.w)};
        float g[8] = {blo(gwd.x), bhi(gwd.x), blo(gwd.y), bhi(gwd.y), blo(gwd.z), bhi(gwd.z), blo(gwd.w), bhi(gwd.w)};
        float s = 0.f;
#pragma unroll
        for (int i = 0; i < 8; ++i) s += o[i];
        s += __shfl_xor(s, 1); s += __shfl_xor(s, 2); s += __shfl_xor(s, 4); s += __shfl_xor(s, 8);
        const float mu = s * (1.0f / 128.0f); float q = 0.f;
#pragma unroll
        for (int i = 0; i < 8; ++i) { o[i] -= mu; q += o[i] * o[i]; }
        q += __shfl_xor(q, 1); q += __shfl_xor(q, 2); q += __shfl_xor(q, 4); q += __shfl_xor(q, 8);
        const float rs = rsqrtf(q * (1.0f / 128.0f) + 1e-6f);
        u32x4 w;
        w.x = pk2(o[0] * rs * silu(g[0]), o[1] * rs * silu(g[1])); w.y = pk2(o[2] * rs * silu(g[2]), o[3] * rs * silu(g[3]));
        w.z = pk2(o[4] * rs * silu(g[4]), o[5] * rs * silu(g[5])); w.w = pk2(o[6] * rs * silu(g[6]), o[7] * rs * silu(g[7]));
        *((u32x4*)(A2 + (size_t)m * DM + 512) + lane) = w;
    }
}
__device__ __forceinline__ void gla_finalize(ArgP a, int li, int gw, int NGW, int lane) {
    unsigned char* ws = a->ws;
    const bf16_t* __restrict__ PROJ = (const bf16_t*)(ws + OFF_HP); const bf16_t* __restrict__ OB = (const bf16_t*)(ws + OFF_O); bf16_t* __restrict__ A2 = (bf16_t*)(ws + OFF_A2);
    const float* ng = a->in[I_GNORM] + li * 256 + 16 * (lane & 15);
    float gn[16];
#pragma unroll
    for (int i = 0; i < 16; ++i) gn[i] = ng[i];
#pragma unroll 4
    for (int m = gw; m < MR; m += NGW) {
        const u32x4 o0 = *((const u32x4*)(OB + (size_t)m * DM) + 2 * lane), o1 = *((const u32x4*)(OB + (size_t)m * DM) + 2 * lane + 1);
        const u32x4 r0 = *((const u32x4*)(PROJ + (size_t)m * NGLAP + 2048) + 2 * lane), r1 = *((const u32x4*)(PROJ + (size_t)m * NGLAP + 2048) + 2 * lane + 1);
        float o[16] = {blo(o0.x), bhi(o0.x), blo(o0.y), bhi(o0.y), blo(o0.z), bhi(o0.z), blo(o0.w), bhi(o0.w), blo(o1.x), bhi(o1.x), blo(o1.y), bhi(o1.y), blo(o1.z), bhi(o1.z), blo(o1.w), bhi(o1.w)};
        float r[16] = {blo(r0.x), bhi(r0.x), blo(r0.y), bhi(r0.y), blo(r0.z), bhi(r0.z), blo(r0.w), bhi(r0.w), blo(r1.x), bhi(r1.x), blo(r1.y), bhi(r1.y), blo(r1.z), bhi(r1.z), blo(r1.w), bhi(r1.w)};
        float q = 0.f;
#pragma unroll
        for (int i = 0; i < 16; ++i) q += o[i] * o[i];
        q += __shfl_xor(q, 1); q += __shfl_xor(q, 2); q += __shfl_xor(q, 4); q += __shfl_xor(q, 8);
        const float rs = rsqrtf(q * (1.0f / 256.0f) + 1e-6f);
        float v[16];
#pragma unroll
        for (int i = 0; i < 16; ++i) v[i] = o[i] * rs * gn[i] * silu(r[i]);
        u32x4 w0, w1;
        w0.x = pk2(v[0], v[1]); w0.y = pk2(v[2], v[3]); w0.z = pk2(v[4], v[5]); w0.w = pk2(v[6], v[7]);
        w1.x = pk2(v[8], v[9]); w1.y = pk2(v[10], v[11]); w1.z = pk2(v[12], v[13]); w1.w = pk2(v[14], v[15]);
        *((u32x4*)(A2 + (size_t)m * DM) + 2 * lane) = w0; *((u32x4*)(A2 + (size_t)m * DM) + 2 * lane + 1) = w1;
    }
}
__device__ __forceinline__ void final_norm(ArgP a, int gw, int NGW, int lane) {
    const bf16_t* __restrict__ XL = (const bf16_t*)(a->ws + OFF_X); const bf16_t* __restrict__ XH = (const bf16_t*)(a->ws + OFF_XB); const float* __restrict__ gfin = a->in[I_NFIN];
#pragma unroll 4
    for (int m = gw; m < MR; m += NGW) {
        float* __restrict__ dst;
        if (m < MP) { const int b = m / LP, t = m - b * LP; if (t < NMETA) continue; dst = a->out + OUT_YP + ((size_t)b * 2048 + (t - NMETA)) * DM; }
        else dst = a->out + OUT_YS + (size_t)(m - MP) * DM;
        f32x4 v[4]; float s = 0.f;
#pragma unroll
        for (int j = 0; j < 4; ++j) { const u32x2 hh = *((const u32x2*)(XH + (size_t)m * DM) + 64 * j + lane), ll = RESID_LO ? *((const u32x2*)(XL + (size_t)m * DM) + 64 * j + lane) : (u32x2){0u, 0u};
            v[j] = (f32x4){blo(hh.x) + blo(ll.x), bhi(hh.x) + bhi(ll.x), blo(hh.y) + blo(ll.y), bhi(hh.y) + bhi(ll.y)}; s += (v[j][0] * v[j][0] + v[j][1] * v[j][1]) + (v[j][2] * v[j][2] + v[j][3] * v[j][3]); }
        const float rs = rsqrtf(wave_sum(s) * (1.0f / 1024.0f) + 1e-6f);
#pragma unroll
        for (int j = 0; j < 4; ++j) { const f32x4 gg = *((const f32x4*)gfin + 64 * j + lane); __builtin_nontemporal_store(v[j] * rs * gg, (f32x4*)dst + 64 * j + lane); }
    }
}

constexpr int PM_SPLIT = 64, ROW_SPLIT = PM_SPLIT * 256;
template <int K>
__device__ __forceinline__ void resid_gemm(const bf16_t* A, const bf16_t* Wt, unsigned char* ws, PG8_LAS unsigned char* ring, int wg, int G, int gw, int NGW, int lane, const XcdBarrier& bar) {
    bf16_t* X = (bf16_t*)(ws + OFF_X); bf16_t* XB = (bf16_t*)(ws + OFF_XB); float* SS = (float*)(ws + OFF_SS);
    {
        pg8::Gemm g{A, Wt, ROW_SPLIT, DM, K, K}; pg8::StaticOrder S; S.init(ROW_SPLIT, DM, G, wg);
        pg8::EpiResid E{X, XB, SS};
        pg8::gemm_phase<pg8::EpiResid, pg8::StaticOrder, false, true>(ring, g, S, E);
#if PROBE_MASK & 4096
        { pg8::EpiProj E2{(bf16_t*)(ws + OFF_O), SS, DM}; pg8::gemm_phase<pg8::EpiProj, pg8::StaticOrder, true, true>(ring, g, S, E2); }
#endif
#if PROBE_MASK & 16384
        { pg8::EpiResidT<true> E2{X, XB, SS}; pg8::gemm_phase<pg8::EpiResidT<true>, pg8::StaticOrder, true, true>(ring, g, S, E2); }
#endif
    }
    {
        int kslice = 256; asm volatile("" : "+s"(kslice));
        pg8::Gemm g{A, Wt, MPAD, DM, kslice, K}; pg8::SplitOrder S{PM_SPLIT, MPAD / 256 - PM_SPLIT, DM / 256, K / 256, 512, G, wg};
        pg8::EpiPart E{(bf16_t*)(ws + OFF_PART), ROW_SPLIT, MPAD - ROW_SPLIT};
        pg8::gemm_phase<pg8::EpiPart, pg8::SplitOrder, true, true>(ring, g, S, E);
#if PROBE_MASK & 8192
        pg8::gemm_phase<pg8::EpiPart, pg8::SplitOrder, true, true>(ring, g, S, E);
#endif
    }
    xcd_barrier(bar);
    constexpr int nks = K / 256;
    const bf16_t* PART = (const bf16_t*)(ws + OFF_PART);
    const int wave_ = gw % NWAVES, wg_ = gw / NWAVES;
    for (int m = ROW_SPLIT + wave_ * G + wg_; m < MPAD; m += NGW) {
        float s = 0.f;
#pragma unroll
        for (int j = 0; j < 4; ++j) {
            const u32x2 hh = *((const u32x2*)(XB + (size_t)m * DM) + 64 * j + lane), ll = RESID_LO ? *((const u32x2*)(X + (size_t)m * DM) + 64 * j + lane) : (u32x2){0u, 0u};
            f32x4 v = {blo(hh.x) + blo(ll.x), bhi(hh.x) + bhi(ll.x), blo(hh.y) + blo(ll.y), bhi(hh.y) + bhi(ll.y)};
            u32x2 p[nks];
#pragma unroll
            for (int ks = 0; ks < nks; ++ks) p[ks] = *((const u32x2*)(PART + ((size_t)ks * (MPAD - ROW_SPLIT) + (m - ROW_SPLIT)) * DM) + 64 * j + lane);
#pragma unroll
            for (int ks = 0; ks < nks; ++ks) v = v + (f32x4){blo(p[ks].x), bhi(p[ks].x), blo(p[ks].y), bhi(p[ks].y)};
            u32x2 w; w.x = pk2(v[0], v[1]); w.y = pk2(v[2], v[3]);
            u32x2 wl; wl.x = pk2(v[0] - blo(w.x), v[1] - bhi(w.x)); wl.y = pk2(v[2] - blo(w.y), v[3] - bhi(w.y));
            *((u32x2*)(XB + (size_t)m * DM) + 64 * j + lane) = w;
            if (RESID_LO) *((u32x2*)(X + (size_t)m * DM) + 64 * j + lane) = wl;
            s += (v[0] * v[0] + v[1] * v[1]) + (v[2] * v[2] + v[3] * v[3]);
        }
        s = wave_sum(s);
        if (lane < 16) SS[(size_t)m * 16 + lane] = (lane == 0) ? s : 0.f;
    }
}

__global__ void __launch_bounds__(NTHR, 2) trunk_fwd(Args args) {
    extern __shared__ __attribute__((aligned(16))) unsigned char lds[];
    const int ph_lo = args.ph_lo, ph_hi = args.ph_hi;
    XcdBarrier bar; bar.bar = nullptr; bar.x = 0; bar.st = nullptr;
    if (ph_hi - ph_lo > 1) {
        volatile LAS unsigned* st = (volatile LAS unsigned*)((LAS unsigned char*)lds + LDS_BYTES - 64);
        if (threadIdx.x < 2) st[threadIdx.x] = 0u;
        __syncthreads();
        bar = xcd_barrier_post((unsigned*)(args.ws + 4096), st);
    }
    for (int ph = ph_lo; ph < ph_hi; ++ph) {
#if PROBE_MASK
      for (int rep = 0; rep < 2; ++rep) {
        if (rep == 1) {
            bool again = false;
            if (ph == 0) again = (PROBE_MASK & 1) != 0; else if (ph == NPHASE - 1) again = (PROBE_MASK & 256) != 0;
            else { const int l_ = (ph - 1) / 10, st_ = (ph - 1) % 10; const bool ev_ = (l_ & 1) == 0;
                if (st_ == 3) again = ev_ ? (PROBE_MASK & 2) != 0 : (PROBE_MASK & 8) != 0;
                else if (st_ == 4) again = ev_ ? (PROBE_MASK & 1024) != 0 : (PROBE_MASK & 2048) != 0;
                else if (st_ == 5) again = ev_ ? (PROBE_MASK & 4) != 0 : (PROBE_MASK & 16) != 0;
                else if (st_ == 0 || st_ == 8) again = (PROBE_MASK & 32) != 0;
                else if (st_ == 2) again = (PROBE_MASK & 64) != 0;
                else if (st_ == 6) again = ev_ && (PROBE_MASK & 128) != 0; }
            if (!again) break;
        }
#endif
        const ArgP ap = arg_ptr();
        const int tid = ltid(), lane = tid & 63, wave = __builtin_amdgcn_readfirstlane(tid >> 6);
        const int wg = lwg(), G = lgrid();
        const int gw = wg * NWAVES + wave, NGW = G * NWAVES;
        unsigned char* ws = ap->ws;
        PG8_LAS unsigned char* ring = (PG8_LAS unsigned char*)lds;
        if (ph == 0) {
            phase_prologue(ap, lds, wg, G);
        } else if (ph == NPHASE - 1) {
            final_norm(ap, gw, NGW, lane);
        } else {
            const int l = (ph - 1) / 10, st = (ph - 1) % 10, li = l >> 1; const bool even = (l & 1) == 0;
            if (st == 0 || st == 8) {
                pg8::Gemm g{(const bf16_t*)(ws + OFF_XB), w_gu(ws, l, st == 8), MPAD, NGU, DM, DM}; pg8::StaticOrder S; S.init(MPAD, NGU, G, wg);
                pg8::EpiGU E{(bf16_t*)(ws + OFF_HP), (const float*)(ws + OFF_SS), DFF};
                pg8::gemm_phase<pg8::EpiGU, pg8::StaticOrder, true, true>(ring, g, S, E);
            } else if (st == 1 || st == 9) {
                resid_gemm<DFF>((const bf16_t*)(ws + OFF_HP), w_dn(ws, l, st == 9), ws, ring, wg, G, gw, NGW, lane, bar);
            } else if (st == 2) {
                const int N = even ? NAB : NGLAP;
                pg8::Gemm g{(const bf16_t*)(ws + OFF_XB), even ? w_abin(ws, li) : w_gin(ws, li), MPAD, N, DM, DM}; pg8::StaticOrder S; S.init(MPAD, N, G, wg);
                pg8::EpiProj E{(bf16_t*)(ws + OFF_HP), (const float*)(ws + OFF_SS), N};
                pg8::gemm_phase<pg8::EpiProj, pg8::StaticOrder, true, true>(ring, g, S, E);
            } else if (st == 3) {
                if (even) { la_prep<64, false>(ap, li, lds, wg, G); __syncthreads(); s5_pass1(ap, li, lds, gw, NGW, lane, wave); }
                else la_prep<128, true>(ap, li, lds, wg, G);
            } else if (st == 4) {
                if (even) { la_prompt<64, 128, 16, false>(ap, li, lds, wg, G); la_sample<64, 128, false>(ap, li, lds, wg, G); __syncthreads(); s5_pass2(ap, li, lds, gw, NGW, lane, wave); }
                else { la_prompt<128, 256, 32, true>(ap, li, lds, wg, G); la_sample<128, 256, true>(ap, li, lds, wg, G); }
            } else if (st == 5) {
                if (even) {
                    pg8::Gemm g{(const bf16_t*)(ws + OFF_Z), w_glu(ws, li), MPAD, 512, 512, 512}; pg8::StaticOrder S; S.init(MPAD, 512, G, wg);
                    pg8::EpiGlu E{(const bf16_t*)(ws + OFF_Z), (bf16_t*)(ws + OFF_A2)};
                    pg8::gemm_phase<pg8::EpiGlu, pg8::StaticOrder, true, true>(ring, g, S, E);
                    ret_finalize(ap, gw, NGW, lane);
                }
                else gla_finalize(ap, li, gw, NGW, lane);
            } else if (st == 6) {
            } else {
                resid_gemm<DM>((const bf16_t*)(ws + OFF_A2), even ? w_about(ws, li) : w_gout(ws, li), ws, ring, wg, G, gw, NGW, lane, bar);
            }
        }
#if PROBE_MASK
      }
#endif
        const bool empty_slot = (ph >= 1 && ph < NPHASE - 1 && ((ph - 1) % 10) == 6);
        if (ph + 1 < ph_hi && !empty_slot) {
            if (ph_hi < 0) { __threadfence(); cg::this_grid().sync(); }
            { xcd_barrier(bar); if (PROBE_MASK & 512) { xcd_barrier(bar); xcd_barrier(bar); } }
        }
    }
}

#ifndef N_LAUNCH_MODE
#define N_LAUNCH_MODE 1
#endif
extern "C" void kernel_launch(void* const* d_in, const int* in_sizes, int n_in, void* d_out, int out_size, void* d_ws, size_t ws_size, hipStream_t stream) {
    static int grid = 0;
    if (grid == 0) {
        if (n_in != N_IN || (size_t)out_size != OUT_END || ws_size < WS_END) { fprintf(stderr, "kernel_launch: unexpected sizes n_in %d out %d ws %zu (need %zu)\n", n_in, out_size, ws_size, (size_t)WS_END); grid = -1; return; }
        int dev = 0, cus = 0, per_cu = 0;
        (void)hipGetDevice(&dev); (void)hipDeviceGetAttribute(&cus, hipDeviceAttributeMultiprocessorCount, dev);
        if (hipFuncSetAttribute((const void*)trunk_fwd, hipFuncAttributeMaxDynamicSharedMemorySize, LDS_BYTES) != hipSuccess) { fprintf(stderr, "kernel_launch: hipFuncSetAttribute failed\n"); grid = -1; return; }
        if (hipOccupancyMaxActiveBlocksPerMultiprocessor(&per_cu, (const void*)trunk_fwd, NTHR, LDS_BYTES) != hipSuccess || per_cu < 1) { fprintf(stderr, "kernel_launch: occupancy query says %d\n", per_cu); per_cu = 1; }
        (void)hipGetLastError();
        grid = cus * 1;
        if (grid <= 0) grid = 256;
    }
    if (grid < 0) return;
    Args a{};
    for (int i = 0; i < N_IN; ++i) a.in[i] = (const float*)d_in[i];
    a.out = (float*)d_out; a.ws = (unsigned char*)d_ws;
#if N_LAUNCH_MODE == 1
    if (hipMemsetAsync(d_ws, 0, 65536, stream) != hipSuccess) { fprintf(stderr, "kernel_launch: memset failed\n"); return; }
    a.ph_lo = 0; a.ph_hi = NPHASE;
    void* kargs[] = {&a};
    hipError_t e = hipLaunchCooperativeKernel((const void*)trunk_fwd, dim3(grid), dim3(NTHR), kargs, LDS_BYTES, stream);
    if (e != hipSuccess) fprintf(stderr, "kernel_launch: cooperative launch failed: %s (grid %d)\n", hipGetErrorString(e), grid);
#else
    for (int ph = 0; ph < NPHASE; ++ph) {
        if (ph >= 1 && ph < NPHASE - 1 && ((ph - 1) % 10) == 6 && (((ph - 1) / 10) & 1)) continue;
        a.ph_lo = ph; a.ph_hi = ph + 1;
        hipLaunchKernelGGL(trunk_fwd, dim3(grid), dim3(NTHR), LDS_BYTES, stream, a);
    }
#endif
}
```

```cpp
#include <hip/hip_runtime.h>
#include <hip/hip_cooperative_groups.h>
#include <cstdio>
#include <cstdint>
namespace cg = cooperative_groups;
#define RESID_LO 0
#define PROBE_MASK 0
__device__ __forceinline__ int ltid() { int t = threadIdx.x; asm volatile("" : "+v"(t)); return t; }
__device__ __forceinline__ int lwg() { int t = blockIdx.x; asm volatile("" : "+s"(t)); return t; }
__device__ __forceinline__ int lgrid() { int t = gridDim.x; asm volatile("" : "+s"(t)); return t; }
namespace pg8 {
#define PG8_LAS __attribute__((address_space(3)))
typedef unsigned short bf16_t;
typedef short bf16x8 __attribute__((ext_vector_type(8)));
typedef float f32x4 __attribute__((ext_vector_type(4)));
typedef unsigned u32x4 __attribute__((ext_vector_type(4)));
constexpr int BM = 256, BK = 64, HALF = 128, HTB = HALF * BK * 2  , STAGE_BYTES = 8 * HTB, NXCD = 8, WGM = 8;

__host__ __device__ __forceinline__ int lds_byte(int r, int c) { const int st = (r >> 4) * 2 + (c >> 5), rr = r & 15, cc = c & 31, ob = rr * 64 + cc * 2; return st * 1024 + (ob ^ (((ob >> 9) & 1) << 5)); }
__host__ __device__ __forceinline__ void stage_rc(int b, int& R, int& C) { const int st = b / 1024, sb = b % 1024, swz = sb ^ (((sb >> 9) & 1) << 5); R = (st >> 1) * 16 + swz / 64; C = (st & 1) * 32 + (swz % 64) / 2; }
__host__ __device__ __forceinline__ int perm32(int rho) { const int n = rho >> 4, i = rho & 15; return 8 * (i >> 2) + 4 * n + (i & 3); }

struct Unit { int pm, pn, kofs; };
struct Gemm { const bf16_t* A; const bf16_t* Bt; int M, N, K, ld; };

struct StaticOrder {
    static constexpr bool SPLIT = false;
    int nM, nN, nwg, G, c;
    __host__ __device__ void init(int M, int N, int G_, int c_) { nM = M / BM; nN = N / BM; nwg = nM * nN; G = G_; c = c_; }
    __host__ __device__ bool next(int i, Unit& u) const {
        const long L = (long)i * G + c; if (L >= nwg) return false;
        int wgid = (int)L; { const int q = nwg / NXCD, r = nwg % NXCD, xcd = wgid % NXCD, off = wgid / NXCD; wgid = (xcd < r ? xcd * (q + 1) : r * (q + 1) + (xcd - r) * q) + off; }
        const int nig = WGM * nN, gid = wgid / nig, fm = gid * WGM, gsz = (nM - fm) < WGM ? (nM - fm) : WGM;
        u.pm = fm + ((wgid % nig) % gsz); u.pn = (wgid % nig) / gsz; u.kofs = 0; return true;
    }
    __device__ __forceinline__ void a_ready(const Unit&) const {}
    __device__ __forceinline__ void done(const Unit&) const {}
};

struct SplitOrder {
    static constexpr bool SPLIT = true;
    int pm0, npm, nN, nks, kslice_bytes, G, c;
    __host__ __device__ bool next(int i, Unit& u) const {
        const long L = (long)i * G + c; if (L >= (long)npm * nN * nks) return false;
        const int l = (int)L; u.kofs = (l % nks) * kslice_bytes; u.pn = (l / nks) % nN; u.pm = pm0 + l / (nks * nN); return true;
    }
    __device__ __forceinline__ void a_ready(const Unit&) const {}
    __device__ __forceinline__ void done(const Unit&) const {}
};
__device__ __forceinline__ unsigned cvt_pk_bf16(float lo, float hi) { unsigned r; asm volatile("v_cvt_pk_bf16_f32 %0, %1, %2" : "=v"(r) : "v"(lo), "v"(hi)); return r; }
typedef float f32x2 __attribute__((ext_vector_type(2)));
typedef unsigned u32x2 __attribute__((ext_vector_type(2)));
__device__ __forceinline__ float row_rs(const float* SS, int row) {
    const f32x4* p = (const f32x4*)(SS + (size_t)row * 16);
    const f32x4 a = p[0], b = p[1], c = p[2], d = p[3];
    const float s = (((a[0] + a[1]) + (a[2] + a[3])) + ((b[0] + b[1]) + (b[2] + b[3]))) + (((c[0] + c[1]) + (c[2] + c[3])) + ((d[0] + d[1]) + (d[2] + d[3])));
    return __builtin_amdgcn_rsqf(s * (1.0f / 1024.0f) + 1e-6f);
}
__device__ __forceinline__ void row_rs8(const float* SS, int row0, int fq, float (&rr)[8]) {
    f32x4 pp[8];
#pragma unroll
    for (int g = 0; g < 8; ++g) pp[g] = *(const f32x4*)(SS + (size_t)(row0 + (g >> 2) * HALF + (g & 3) * 16) * 16 + 4 * fq);
#pragma unroll
    for (int g = 0; g < 8; ++g) {
        float s = (pp[g][0] + pp[g][1]) + (pp[g][2] + pp[g][3]);
        s += __shfl_xor(s, 16); s += __shfl_xor(s, 32);
        rr[g] = __builtin_amdgcn_rsqf(s * (1.0f / 1024.0f) + 1e-6f);
    }
}
__device__ __forceinline__ float silu_f(float x) { return x * __builtin_amdgcn_rcpf(1.0f + __expf(-x)); }
__device__ __forceinline__ float sigm_f(float x) { return __builtin_amdgcn_rcpf(1.0f + __expf(-x)); }
__device__ __forceinline__ float bfu_lo(unsigned w) { return __uint_as_float(w << 16); }
__device__ __forceinline__ float bfu_hi(unsigned w) { return __uint_as_float(w & 0xffff0000u); }

struct EpiGU {
    static constexpr bool PERM = true, AFTER_DRAIN = false;
    bf16_t* H; const float* SS; int ldh;
    __device__ __forceinline__ void operator()(const f32x4 (&acc)[2][2][4][2], const Unit& u, int wr, int wc, int fr, int fq) const {
        const int row0 = u.pm * BM + wr * 64 + fr, col0 = u.pn * 128 + wc * 32 + 8 * fq;
        float rr[8]; row_rs8(SS, row0, fq, rr);
#pragma unroll
        for (int ai = 0; ai < 2; ++ai)
#pragma unroll
            for (int m = 0; m < 4; ++m) {
                const int row = row0 + ai * HALF + m * 16; const float r = rr[ai * 4 + m];
                const f32x4 g0 = acc[ai][0][m][0] * r, g1 = acc[ai][0][m][1] * r, u0 = acc[ai][1][m][0] * r, u1 = acc[ai][1][m][1] * r;
                u32x4 w;
                w.x = cvt_pk_bf16(silu_f(g0[0]) * u0[0], silu_f(g0[1]) * u0[1]); w.y = cvt_pk_bf16(silu_f(g0[2]) * u0[2], silu_f(g0[3]) * u0[3]);
                w.z = cvt_pk_bf16(silu_f(g1[0]) * u1[0], silu_f(g1[1]) * u1[1]); w.w = cvt_pk_bf16(silu_f(g1[2]) * u1[2], silu_f(g1[3]) * u1[3]);
                *(u32x4*)(H + (size_t)row * ldh + col0) = w;
            }
    }
};
struct EpiProj {
    static constexpr bool PERM = true, AFTER_DRAIN = false;
    bf16_t* O; const float* SS; int ldc;
    __device__ __forceinline__ void operator()(const f32x4 (&acc)[2][2][4][2], const Unit& u, int wr, int wc, int fr, int fq) const {
        const int row0 = u.pm * BM + wr * 64 + fr, col0 = u.pn * BM + wc * 32 + 8 * fq;
        float rr[8]; row_rs8(SS, row0, fq, rr);
#pragma unroll
        for (int ai = 0; ai < 2; ++ai)
#pragma unroll
            for (int m = 0; m < 4; ++m) {
                const int row = row0 + ai * HALF + m * 16; const float r = rr[ai * 4 + m];
#pragma unroll
                for (int bj = 0; bj < 2; ++bj) {
                    const f32x4 v0 = acc[ai][bj][m][0] * r, v1 = acc[ai][bj][m][1] * r;
                    u32x4 w; w.x = cvt_pk_bf16(v0[0], v0[1]); w.y = cvt_pk_bf16(v0[2], v0[3]); w.z = cvt_pk_bf16(v1[0], v1[1]); w.w = cvt_pk_bf16(v1[2], v1[3]);
                    *(u32x4*)(O + (size_t)row * ldc + col0 + bj * HALF) = w;
                }
            }
    }
};
template <bool ZERO = false> struct EpiResidT {
    static constexpr bool PERM = true, AFTER_DRAIN = false;
    bf16_t* XL; bf16_t* XB; float* SS;
    __device__ __forceinline__ void operator()(const f32x4 (&acc)[2][2][4][2], const Unit& u, int wr, int wc, int fr, int fq) const {
        const int row0 = u.pm * BM + wr * 64 + fr, col0 = u.pn * BM + wc * 32 + 8 * fq;
        u32x4 xin[2][4];
#pragma unroll
        for (int bj = 0; bj < 2; ++bj) { const size_t o = (size_t)row0 * 1024 + col0 + bj * HALF; xin[0][2 * bj] = *(const u32x4*)(XB + o); xin[0][2 * bj + 1] = RESID_LO ? *(const u32x4*)(XL + o) : (u32x4){0u, 0u, 0u, 0u}; }
#pragma unroll
        for (int gI = 0; gI < 8; ++gI) {
            const int ai = gI >> 2, m = gI & 3, cur = gI & 1, nxt = cur ^ 1;
            const int row = row0 + ai * HALF + m * 16;
            if (gI + 1 < 8) {
                const int rown = row0 + ((gI + 1) >> 2) * HALF + ((gI + 1) & 3) * 16;
#pragma unroll
                for (int bj = 0; bj < 2; ++bj) { const size_t o = (size_t)rown * 1024 + col0 + bj * HALF; xin[nxt][2 * bj] = *(const u32x4*)(XB + o); xin[nxt][2 * bj + 1] = RESID_LO ? *(const u32x4*)(XL + o) : (u32x4){0u, 0u, 0u, 0u}; }
            }
            float ss = 0.f;
#pragma unroll
            for (int bj = 0; bj < 2; ++bj) {
                const size_t o = (size_t)row * 1024 + col0 + bj * HALF;
                const u32x4 h = xin[cur][2 * bj], l = xin[cur][2 * bj + 1];
                f32x4 x0 = {bfu_lo(h.x) + bfu_lo(l.x), bfu_hi(h.x) + bfu_hi(l.x), bfu_lo(h.y) + bfu_lo(l.y), bfu_hi(h.y) + bfu_hi(l.y)};
                f32x4 x1 = {bfu_lo(h.z) + bfu_lo(l.z), bfu_hi(h.z) + bfu_hi(l.z), bfu_lo(h.w) + bfu_lo(l.w), bfu_hi(h.w) + bfu_hi(l.w)};
                if (!ZERO) { x0 = x0 + acc[ai][bj][m][0]; x1 = x1 + acc[ai][bj][m][1]; } else { x0 = x0 + acc[ai][bj][m][0] * 0.f; x1 = x1 + acc[ai][bj][m][1] * 0.f; }
                ss += ((x0[0] * x0[0] + x0[1] * x0[1]) + (x0[2] * x0[2] + x0[3] * x0[3])) + ((x1[0] * x1[0] + x1[1] * x1[1]) + (x1[2] * x1[2] + x1[3] * x1[3]));
                u32x4 wh; wh.x = cvt_pk_bf16(x0[0], x0[1]); wh.y = cvt_pk_bf16(x0[2], x0[3]); wh.z = cvt_pk_bf16(x1[0], x1[1]); wh.w = cvt_pk_bf16(x1[2], x1[3]);
                u32x4 wl;
                wl.x = cvt_pk_bf16(x0[0] - bfu_lo(wh.x), x0[1] - bfu_hi(wh.x)); wl.y = cvt_pk_bf16(x0[2] - bfu_lo(wh.y), x0[3] - bfu_hi(wh.y));
                wl.z = cvt_pk_bf16(x1[0] - bfu_lo(wh.z), x1[1] - bfu_hi(wh.z)); wl.w = cvt_pk_bf16(x1[2] - bfu_lo(wh.w), x1[3] - bfu_hi(wh.w));
                *(u32x4*)(XB + o) = wh; if (RESID_LO) *(u32x4*)(XL + o) = wl;
            }
            ss += __shfl_xor(ss, 16); ss += __shfl_xor(ss, 32);
            if (fq == 0) SS[(size_t)row * 16 + u.pn * 4 + wc] = ss;
        }
    }
};
typedef EpiResidT<false> EpiResid;
struct EpiGlu {
    static constexpr bool PERM = true, AFTER_DRAIN = false;
    const bf16_t* Z; bf16_t* A2;
    __device__ __forceinline__ void operator()(const f32x4 (&acc)[2][2][4][2], const Unit& u, int wr, int wc, int fr, int fq) const {
        const int row0 = u.pm * BM + wr * 64 + fr, col0 = u.pn * BM + wc * 32 + 8 * fq;
#pragma unroll
        for (int ai = 0; ai < 2; ++ai) {
            u32x4 zz[4][2];
#pragma unroll
            for (int m = 0; m < 4; ++m)
#pragma unroll
                for (int bj = 0; bj < 2; ++bj) zz[m][bj] = *(const u32x4*)(Z + (size_t)(row0 + ai * HALF + m * 16) * 512 + col0 + bj * HALF);
#pragma unroll
            for (int m = 0; m < 4; ++m) {
                const int row = row0 + ai * HALF + m * 16;
#pragma unroll
                for (int bj = 0; bj < 2; ++bj) {
                    const u32x4 z = zz[m][bj];
                    const f32x4 v0 = acc[ai][bj][m][0], v1 = acc[ai][bj][m][1];
                    u32x4 w;
                    w.x = cvt_pk_bf16(bfu_lo(z.x) * sigm_f(v0[0]), bfu_hi(z.x) * sigm_f(v0[1])); w.y = cvt_pk_bf16(bfu_lo(z.y) * sigm_f(v0[2]), bfu_hi(z.y) * sigm_f(v0[3]));
                    w.z = cvt_pk_bf16(bfu_lo(z.z) * sigm_f(v1[0]), bfu_hi(z.z) * sigm_f(v1[1])); w.w = cvt_pk_bf16(bfu_lo(z.w) * sigm_f(v1[2]), bfu_hi(z.w) * sigm_f(v1[3]));
                    *(u32x4*)(A2 + (size_t)row * 1024 + col0 + bj * HALF) = w;
                }
            }
        }
    }
};
struct EpiPart {
    static constexpr bool PERM = true, AFTER_DRAIN = false;
    bf16_t* P; int row_base, nrows;
    __device__ __forceinline__ void operator()(const f32x4 (&acc)[2][2][4][2], const Unit& u, int wr, int wc, int fr, int fq) const {
        const int row0 = u.pm * BM + wr * 64 + fr - row_base, col0 = u.pn * BM + wc * 32 + 8 * fq;
        bf16_t* base = P + (size_t)(u.kofs >> 9) * nrows * 1024;
#pragma unroll
        for (int ai = 0; ai < 2; ++ai)
#pragma unroll
            for (int m = 0; m < 4; ++m) {
                const int row = row0 + ai * HALF + m * 16;
#pragma unroll
                for (int bj = 0; bj < 2; ++bj) {
                    const f32x4 v0 = acc[ai][bj][m][0], v1 = acc[ai][bj][m][1];
                    u32x4 w; w.x = cvt_pk_bf16(v0[0], v0[1]); w.y = cvt_pk_bf16(v0[2], v0[3]); w.z = cvt_pk_bf16(v1[0], v1[1]); w.w = cvt_pk_bf16(v1[2], v1[3]);
                    *(u32x4*)(base + (size_t)row * 1024 + col0 + bj * HALF) = w;
                }
            }
    }
};
template <class Epi, class Sched, bool ALIGN_EPI = false, bool SP2 = false>
__device__ __forceinline__ void gemm_phase(PG8_LAS unsigned char* lds, const Gemm g, const Sched& S, const Epi& E) {
    const int tid = ltid(), wid = __builtin_amdgcn_readfirstlane(tid >> 6), lane = tid & 63, wr = wid >> 2, wc = wid & 3, fr = lane & 15, fq = lane >> 4;
    const int K = g.ld, nt = g.K / BK;
    unsigned voffA[2], voffB[2];
#pragma unroll
    for (int i = 0; i < 2; ++i) { int R, C; stage_rc(tid * 16 + i * 8192, R, C); const int Rb = Epi::PERM ? ((R & ~31) + perm32(R & 31)) : R;
        voffA[i] = (unsigned)(R * K + C) * 2u; voffB[i] = (unsigned)(Rb * K + C) * 2u; }
    const size_t kstep = (size_t)(BK * 2);
    const size_t hstep = (size_t)HALF * K * 2;
    const size_t tstep = 2 * hstep;
    const unsigned ldsw = (unsigned)wid * 1024u;
    const int aoff = lds_byte(wr * 64 + fr, fq * 8), boff = lds_byte(wc * 32 + fr, fq * 8);
#define PG8_SA(b, h) (((b) * 2 + (h)) * HTB)
#define PG8_SB(b, h) ((4 + (b) * 2 + (h)) * HTB)
#define PG8_STAGE(bufoff, gbase, voff) do { _Pragma("unroll") for (int _i = 0; _i < 2; ++_i) \
        __builtin_amdgcn_global_load_lds((const unsigned*)((const char*)(gbase) + (voff)[_i]), (PG8_LAS unsigned*)(lds + (bufoff) + ldsw + _i * 8192), 16, 0, 0); } while (0)
#define PG8_LDA(dst, b, h) do { _Pragma("unroll") for (int m = 0; m < 4; ++m) _Pragma("unroll") for (int k = 0; k < 2; ++k) dst[m][k] = *(const PG8_LAS bf16x8*)(lds + PG8_SA(b, h) + aoff + m * 2048 + k * 1024); } while (0)
#define PG8_LDB(dst, b, h) do { _Pragma("unroll") for (int n = 0; n < 2; ++n) _Pragma("unroll") for (int k = 0; k < 2; ++k) dst[n][k] = *(const PG8_LAS bf16x8*)(lds + PG8_SB(b, h) + boff + n * 2048 + k * 1024); } while (0)
#define PG8_MMA(ai, bj, At, Bt) do { __builtin_amdgcn_s_setprio(1); _Pragma("unroll") for (int m = 0; m < 4; ++m) _Pragma("unroll") for (int n = 0; n < 2; ++n) _Pragma("unroll") for (int k = 0; k < 2; ++k) \
        acc[ai][bj][m][n] = __builtin_amdgcn_mfma_f32_16x16x32_bf16(Bt[n][k], At[m][k], acc[ai][bj][m][n], 0, 0, 0); __builtin_amdgcn_s_setprio(0); } while (0)
#define PG8_WAIT_V(n) asm volatile("s_waitcnt vmcnt(" #n ")" ::: "memory")
#define PG8_WAIT_L(n) asm volatile("s_waitcnt lgkmcnt(" #n ")" ::: "memory")
#define PG8_BAR __builtin_amdgcn_s_barrier()
#define PG8_SCHED __builtin_amdgcn_sched_barrier(0)
    Unit cur, nxt; int ui = 0;
    if (!S.next(0, cur)) return;
    f32x4 acc[2][2][4][2];
#pragma unroll
    for (int a = 0; a < 2; ++a)
#pragma unroll
        for (int b = 0; b < 2; ++b)
#pragma unroll
            for (int m = 0; m < 4; ++m)
#pragma unroll
                for (int n = 0; n < 2; ++n) acc[a][b][m][n] = (f32x4){0.f, 0.f, 0.f, 0.f};
    bf16x8 At[4][2], B0[2][2], B1[2][2];
    const char* cA = (const char*)g.A + (size_t)cur.pm * tstep + (Sched::SPLIT ? cur.kofs : 0); const char* cB = (const char*)g.Bt + (size_t)cur.pn * tstep + (Sched::SPLIT ? cur.kofs : 0);
    S.a_ready(cur);
    if constexpr (SP2) {
        PG8_STAGE(PG8_SB(0, 0), cB, voffB); PG8_STAGE(PG8_SB(0, 1), cB + hstep, voffB); PG8_STAGE(PG8_SA(0, 0), cA, voffA); PG8_STAGE(PG8_SA(0, 1), cA + hstep, voffA);
        if (wr == 1) PG8_BAR;
        PG8_WAIT_V(2); PG8_BAR;
        PG8_STAGE(PG8_SB(1, 0), cB + kstep, voffB); PG8_STAGE(PG8_SA(1, 0), cA + kstep, voffA); PG8_STAGE(PG8_SB(1, 1), cB + hstep + kstep, voffB);
        PG8_WAIT_V(6); PG8_BAR;
    } else {
        PG8_STAGE(PG8_SB(0, 0), cB, voffB); PG8_STAGE(PG8_SA(0, 0), cA, voffA); PG8_STAGE(PG8_SB(0, 1), cB + hstep, voffB); PG8_STAGE(PG8_SA(0, 1), cA + hstep, voffA);
        if (wr == 1) PG8_BAR;
        PG8_WAIT_V(4); PG8_BAR;
        PG8_STAGE(PG8_SB(1, 0), cB + kstep, voffB); PG8_STAGE(PG8_SA(1, 0), cA + kstep, voffA); PG8_STAGE(PG8_SB(1, 1), cB + hstep + kstep, voffB);
        PG8_WAIT_V(6); PG8_BAR;
    }
    for (;;) {
        const bool has_next = S.next(ui + 1, nxt);
        const char* nA = has_next ? (const char*)g.A + (size_t)nxt.pm * tstep + (Sched::SPLIT ? nxt.kofs : 0) : cA; const char* nB = has_next ? (const char*)g.Bt + (size_t)nxt.pn * tstep + (Sched::SPLIT ? nxt.kofs : 0) : cB;
        for (int t = 0; t < nt; t += 2) {
            const bool last = (t == nt - 2);
            const char* a1 = cA + (size_t)(t + 1) * kstep;
            const char* a2 = last ? nA : cA + (size_t)(t + 2) * kstep; const char* b2 = last ? nB : cB + (size_t)(t + 2) * kstep;
            const char* a3 = a2 + kstep; const char* b3 = b2 + kstep;
            if (last && has_next) S.a_ready(nxt);
            if constexpr (SP2) {
            PG8_LDB(B0, 0, 0); PG8_LDB(B1, 0, 1); PG8_SCHED; PG8_LDA(At, 0, 0); PG8_STAGE(PG8_SA(1, 1), a1 + hstep, voffA);
            PG8_WAIT_V(8); PG8_WAIT_L(0); PG8_BAR; PG8_MMA(0, 0, At, B0); PG8_MMA(0, 1, At, B1); PG8_BAR; PG8_SCHED;
            PG8_LDA(At, 0, 1); PG8_STAGE(PG8_SB(0, 0), b2, voffB); PG8_STAGE(PG8_SB(0, 1), b2 + hstep, voffB); PG8_STAGE(PG8_SA(0, 0), a2, voffA);
            PG8_WAIT_V(8); PG8_WAIT_L(0); PG8_BAR; PG8_MMA(1, 0, At, B0); PG8_MMA(1, 1, At, B1); PG8_BAR; PG8_SCHED;
            PG8_LDB(B0, 1, 0); PG8_LDB(B1, 1, 1); PG8_SCHED; PG8_LDA(At, 1, 0); PG8_STAGE(PG8_SA(0, 1), a2 + hstep, voffA);
            PG8_WAIT_V(8); PG8_WAIT_L(0); PG8_BAR; PG8_MMA(0, 0, At, B0); PG8_MMA(0, 1, At, B1); PG8_BAR; PG8_SCHED;
            PG8_LDA(At, 1, 1); PG8_STAGE(PG8_SB(1, 0), b3, voffB); PG8_STAGE(PG8_SB(1, 1), b3 + hstep, voffB); PG8_STAGE(PG8_SA(1, 0), a3, voffA);
            PG8_WAIT_V(8); PG8_WAIT_L(0); PG8_BAR; PG8_MMA(1, 0, At, B0); PG8_MMA(1, 1, At, B1); PG8_BAR; PG8_SCHED;
            } else {
            PG8_LDB(B0, 0, 0); PG8_SCHED; PG8_LDA(At, 0, 0); PG8_STAGE(PG8_SA(1, 1), a1 + hstep, voffA);
            PG8_WAIT_L(8); PG8_BAR; PG8_WAIT_L(0); PG8_MMA(0, 0, At, B0); PG8_BAR; PG8_SCHED;
            PG8_LDB(B1, 0, 1); PG8_STAGE(PG8_SB(0, 0), b2, voffB);
            PG8_BAR; PG8_WAIT_L(0); PG8_MMA(0, 1, At, B1); PG8_BAR;
            PG8_LDA(At, 0, 1); PG8_STAGE(PG8_SA(0, 0), a2, voffA);
            PG8_BAR; PG8_WAIT_L(0); PG8_MMA(1, 0, At, B0); PG8_BAR; PG8_SCHED;
            PG8_STAGE(PG8_SB(0, 1), b2 + hstep, voffB);
            PG8_WAIT_V(6); PG8_BAR; PG8_MMA(1, 1, At, B1); PG8_BAR;
            PG8_LDB(B0, 1, 0); PG8_SCHED; PG8_LDA(At, 1, 0); PG8_STAGE(PG8_SA(0, 1), a2 + hstep, voffA);
            PG8_WAIT_L(8); PG8_BAR; PG8_WAIT_L(0); PG8_MMA(0, 0, At, B0); PG8_BAR; PG8_SCHED;
            PG8_LDB(B1, 1, 1); PG8_STAGE(PG8_SB(1, 0), b3, voffB);
            PG8_BAR; PG8_WAIT_L(0); PG8_MMA(0, 1, At, B1); PG8_BAR;
            PG8_LDA(At, 1, 1); PG8_STAGE(PG8_SA(1, 0), a3, voffA);
            PG8_BAR; PG8_WAIT_L(0); PG8_MMA(1, 0, At, B0); PG8_BAR; PG8_SCHED;
            PG8_STAGE(PG8_SB(1, 1), b3 + hstep, voffB);
            PG8_WAIT_V(6); PG8_BAR; PG8_MMA(1, 1, At, B1); PG8_BAR;
            }
        }
        if constexpr (ALIGN_EPI) { if (wr == 0) PG8_BAR; }
        if constexpr (!Epi::AFTER_DRAIN) { E(acc, cur, wr, wc, fr, fq); S.done(cur); }
        if (!has_next) break;
#pragma unroll
        for (int a = 0; a < 2; ++a)
#pragma unroll
            for (int b = 0; b < 2; ++b)
#pragma unroll
                for (int m = 0; m < 4; ++m)
#pragma unroll
                    for (int n = 0; n < 2; ++n) acc[a][b][m][n] = (f32x4){0.f, 0.f, 0.f, 0.f};
        cur = nxt; cA = nA; cB = nB; ++ui;
        if constexpr (ALIGN_EPI) { if (wr == 1) PG8_BAR; }
    }
    PG8_WAIT_V(0);
    if constexpr (!ALIGN_EPI) { if (wr == 0) PG8_BAR; }
    PG8_BAR;
    if constexpr (Epi::AFTER_DRAIN) { E.fused(acc, cur, wr, wc, fr, fq, lds, wid, lane); S.done(cur); }
#undef PG8_SA
#undef PG8_SB
#undef PG8_STAGE
#undef PG8_LDA
#undef PG8_LDB
#undef PG8_MMA
#undef PG8_WAIT_V
#undef PG8_WAIT_L
#undef PG8_BAR
#undef PG8_SCHED
}
}
#define LAS __attribute__((address_space(3)))
#define XB_TMO      128
#define XB_XCNT(j)  (256  + 64 * (j))
#define XB_XSUB(j)  (1280 + 64 * (j))
#define XB_XGEN(j)  (2304 + 64 * (j))
#define XB_TOP      3328
#define XB_TOPGEN   3392
#define XCD_BAR_WORDS 3456
#define XB_SPIN_CAP (1u << 18)

__device__ __forceinline__ unsigned xb_ld(unsigned* p)              { return __hip_atomic_load(p, __ATOMIC_RELAXED, __HIP_MEMORY_SCOPE_AGENT); }
__device__ __forceinline__ unsigned xb_add(unsigned* p, unsigned v) { return __hip_atomic_fetch_add(p, v, __ATOMIC_RELAXED, __HIP_MEMORY_SCOPE_AGENT); }
__device__ __forceinline__ unsigned xb_xcc_id() { return (unsigned)__builtin_amdgcn_s_getreg((3 << 11) | 20) & 0xFu; }
#define XB_SPIN(cond, bar) do { unsigned _sp = 0; while (cond) { __builtin_amdgcn_s_sleep(1); \
    if ((++_sp & 255u) == 0u) { if (xb_ld(&(bar)[XB_TMO])) break; if (_sp > XB_SPIN_CAP) { atomicAdd(&(bar)[XB_TMO], 1u); break; } } } } while (0)

struct XcdBarrier {
    unsigned* bar; unsigned x;
    volatile LAS unsigned* st;
};

__device__ __forceinline__ XcdBarrier xcd_barrier_post(unsigned* bar, volatile LAS unsigned* st) {
    XcdBarrier b; b.bar = bar; b.x = xb_xcc_id(); b.st = st;
    if (threadIdx.x == 0) (void)xb_add(&bar[XB_XCNT(b.x)], 1u);
    return b;
}
__device__ __forceinline__ void xcd_barrier_complete(unsigned* bar, unsigned x, unsigned& nloc, unsigned& nx) {
    const unsigned G = gridDim.x * gridDim.y * gridDim.z;
    unsigned sum, cnt, mine, sp = 0u;
    for (;;) {
        sum = 0u; cnt = 0u; mine = 0u;
#pragma unroll
        for (unsigned j = 0; j < 16; ++j) { const unsigned c = xb_ld(&bar[XB_XCNT(j)]); sum += c; cnt += (c > 0u) ? 1u : 0u; mine = (j == x) ? c : mine; }
        if (sum == G) break;
        __builtin_amdgcn_s_sleep(1);
        if ((++sp & 255u) == 0u) { if (xb_ld(&bar[XB_TMO])) break; if (sp > XB_SPIN_CAP) { atomicAdd(&bar[XB_TMO], 1u); break; } }
    }
    nloc = mine > 0u ? mine : 1u; nx = cnt > 0u ? cnt : 1u;
}

__device__ __forceinline__ void xcd_barrier(const XcdBarrier& b) {
    asm volatile("s_waitcnt vmcnt(0)" ::: "memory");
    __syncthreads();
    if (threadIdx.x == 0) {
        unsigned* bar = b.bar;
        __builtin_amdgcn_s_waitcnt(0);
        unsigned nloc = b.st[0], nx = b.st[1];
        if (nloc == 0u) { xcd_barrier_complete(bar, b.x, nloc, nx); b.st[0] = nloc; b.st[1] = nx; }
        const unsigned old = xb_add(&bar[XB_XSUB(b.x)], 1u);
        const unsigned gen = old / nloc;
        if (old + 1u == (gen + 1u) * nloc) {
            __builtin_amdgcn_fence(__ATOMIC_RELEASE, "agent");
            asm volatile("s_waitcnt vmcnt(0)" ::: "memory");
            const unsigned og = xb_add(&bar[XB_TOP], 1u);
            const unsigned tg = og / nx;
            if (og + 1u == (tg + 1u) * nx) xb_add(&bar[XB_TOPGEN], 1u);
            else XB_SPIN(xb_ld(&bar[XB_TOPGEN]) == tg, bar);
            __builtin_amdgcn_fence(__ATOMIC_ACQUIRE, "agent");
            xb_add(&bar[XB_XGEN(b.x)], 1u);
            asm volatile("s_waitcnt vmcnt(0)" ::: "memory");
        } else {
            XB_SPIN(xb_ld(&bar[XB_XGEN(b.x)]) == gen, bar);
            __builtin_amdgcn_fence(__ATOMIC_ACQUIRE, "agent");
            asm volatile("s_waitcnt vmcnt(0)" ::: "memory");
        }
    }
    __syncthreads();
}
typedef unsigned short bf16_t;
typedef float f32x4 __attribute__((ext_vector_type(4)));
typedef short bf16x8 __attribute__((ext_vector_type(8)));
typedef unsigned u32x4 __attribute__((ext_vector_type(4)));
typedef unsigned u32x2 __attribute__((ext_vector_type(2)));
constexpr int DM = 1024, NB = 8, LP = 2064, NSB = 128, NST = 8, NMETA = 16;
constexpr int MP = NB * LP;
constexpr int MR = MP + NSB * NST;
constexpr int MPAD = 17664;
constexpr int DFF = 2816, NGU = 5632, NAB = 2048, NGLA = 3088, NGLAP = 3328;
constexpr int NWAVES = 8, NTHR = 512;
constexpr int LDS_BYTES = 147456, RING_BYTES = 131072;
constexpr int NPHASE = 42;
constexpr size_t SZ_WGU = (size_t)NGU * DM * 2, SZ_WD = (size_t)DM * DFF * 2, SZ_FFN = 2 * (SZ_WGU + SZ_WD);
constexpr size_t SZ_WINAB = (size_t)NAB * DM * 2, SZ_WGLU = 512 * 512 * 2, SZ_WOUT = (size_t)DM * DM * 2, SZ_AB = SZ_WINAB + SZ_WGLU + SZ_WOUT;
constexpr size_t SZ_WING = (size_t)NGLAP * DM * 2, SZ_G = SZ_WING + SZ_WOUT;
constexpr size_t OFF_W = 1u << 20;
constexpr size_t OFF_WAB = OFF_W + 4 * SZ_FFN, OFF_WG = OFF_WAB + 2 * SZ_AB;
constexpr size_t OFF_X = OFF_WG + 2 * SZ_G;
constexpr size_t OFF_XB = OFF_X + (size_t)MPAD * DM * 4;
constexpr size_t OFF_SS = OFF_XB + (size_t)MPAD * DM * 2;
constexpr size_t OFF_HP = OFF_SS + (size_t)MPAD * 16 * 4;
constexpr size_t OFF_A2 = OFF_HP + (size_t)MPAD * NGLAP * 2;
constexpr size_t OFF_Z = OFF_A2 + (size_t)MPAD * DM * 2;
constexpr size_t OFF_O = OFF_Z + (size_t)MPAD * 512 * 2;
constexpr size_t OFF_ROT = OFF_O + (size_t)MPAD * DM * 2;
constexpr int NROT = 2072;
constexpr size_t OFF_S5T = OFF_ROT + (size_t)NROT * 32 * 2 * 4;
constexpr size_t S5T_STRIDE_F = 32 * 64 * 2 + 32 * 64 * 32;
constexpr size_t OFF_S5E = OFF_S5T + 2 * S5T_STRIDE_F * 4;
constexpr size_t OFF_PART = OFF_S5E + (size_t)8 * 32 * 16 * 128 * 4;
constexpr size_t WS_END = OFF_PART + (size_t)11 * 1280 * 1024 * 4;
static_assert(OFF_X % 256 == 0 && OFF_HP % 256 == 0 && OFF_ROT % 256 == 0 && OFF_S5E % 256 == 0, "ws alignment");
constexpr size_t OUT_YP = 0, OUT_YS = OUT_YP + (size_t)NB * 2048 * DM, OUT_PS5R = OUT_YS + (size_t)NSB * NST * DM, OUT_PS5I = OUT_PS5R + 2 * 8 * 32 * 64,
                 OUT_PRET = OUT_PS5I + 2 * 8 * 32 * 64, OUT_PGLA = OUT_PRET + (size_t)2 * 8 * 4 * 64 * 128, OUT_SS5R = OUT_PGLA + (size_t)2 * 8 * 4 * 128 * 256,
                 OUT_SS5I = OUT_SS5R + (size_t)2 * 128 * 32 * 64, OUT_SRET = OUT_SS5I + (size_t)2 * 128 * 32 * 64, OUT_SGLA = OUT_SRET + (size_t)2 * 128 * 4 * 64 * 128,
                 OUT_END = OUT_SGLA + (size_t)2 * 128 * 4 * 128 * 256;
enum { I_XP = 0, I_XS, I_S5R, I_S5I, I_SRET, I_SGLA, I_META, I_NF1, I_NMIX, I_NF2, I_NFIN, I_F1GU, I_F1D, I_F2GU, I_F2D, I_ABIN, I_ABOUT, I_S5AR, I_S5AI, I_S5DT,
       I_S5BR, I_S5BI, I_S5CR, I_S5CI, I_S5D, I_S5GLU, I_GIN, I_GA2, I_GBA, I_GNORM, I_GOUT, N_IN };

struct Args { const float* in[N_IN]; float* out; unsigned char* ws; int ph_lo, ph_hi; };
typedef const __attribute__((address_space(4))) Args* ArgP;
__device__ __forceinline__ ArgP arg_ptr() { ArgP p = (ArgP)__builtin_amdgcn_kernarg_segment_ptr(); asm volatile("" : "+s"(p)); return p; }

__device__ __forceinline__ float bf2f(bf16_t v) { return __uint_as_float((unsigned)v << 16); }
__device__ __forceinline__ bf16_t f2bf(float f) { const unsigned u = __float_as_uint(f); return (bf16_t)((u + 0x7fffu + ((u >> 16) & 1u)) >> 16); }
__device__ __forceinline__ unsigned pk2(float lo, float hi) { return (unsigned)f2bf(lo) | ((unsigned)f2bf(hi) << 16); }
__device__ __forceinline__ float blo(unsigned w) { return __uint_as_float(w << 16); }
__device__ __forceinline__ float bhi(unsigned w) { return __uint_as_float(w & 0xffff0000u); }
__device__ __forceinline__ float wave_sum(float v) {
#pragma unroll
    for (int o = 1; o < 64; o <<= 1) v += __shfl_xor(v, o);
    return v;
}
__device__ __forceinline__ float silu(float x) { return x / (1.0f + __expf(-x)); }
__device__ __forceinline__ float gelu_tanh(float y) {
    const float v = 0.7978845608028654f * (y + 0.044715f * y * y * y);
    const float th = 1.0f - 2.0f / (__expf(2.0f * v) + 1.0f);
    return 0.5f * y * (1.0f + th);
}
__device__ __forceinline__ float logsig(float x) { return fminf(x, 0.f) - __logf(1.0f + __expf(-fabsf(x))); }
#define LDS_FENCE() asm volatile("s_waitcnt lgkmcnt(0)" ::: "memory")

__device__ __forceinline__ bf16_t* w_gu(unsigned char* ws, int l, int which) { return (bf16_t*)(ws + OFF_W + (size_t)l * SZ_FFN + (size_t)which * (SZ_WGU + SZ_WD)); }
__device__ __forceinline__ bf16_t* w_dn(unsigned char* ws, int l, int which) { return (bf16_t*)(ws + OFF_W + (size_t)l * SZ_FFN + (size_t)which * (SZ_WGU + SZ_WD) + SZ_WGU); }
__device__ __forceinline__ bf16_t* w_abin(unsigned char* ws, int i) { return (bf16_t*)(ws + OFF_WAB + (size_t)i * SZ_AB); }
__device__ __forceinline__ bf16_t* w_glu(unsigned char* ws, int i) { return (bf16_t*)(ws + OFF_WAB + (size_t)i * SZ_AB + SZ_WINAB); }
__device__ __forceinline__ bf16_t* w_about(unsigned char* ws, int i) { return (bf16_t*)(ws + OFF_WAB + (size_t)i * SZ_AB + SZ_WINAB + SZ_WGLU); }
__device__ __forceinline__ bf16_t* w_gin(unsigned char* ws, int i) { return (bf16_t*)(ws + OFF_WG + (size_t)i * SZ_G); }
__device__ __forceinline__ bf16_t* w_gout(unsigned char* ws, int i) { return (bf16_t*)(ws + OFF_WG + (size_t)i * SZ_G + SZ_WING); }

__device__ __forceinline__ void transpose_item(const float* W, int K, int Nsrc, bf16_t* WT, const float* gain, float scale, int mode, float* scr, int item, int nblk, int lane) {
    const int kb = item / nblk, nb = item - kb * nblk, k0 = 64 * kb, n0 = 64 * nb;
    int sc0;
    if (mode == 1) { const int t = n0 >> 8, w = n0 & 255; sc0 = (w < 128) ? (t * 128 + w) : (DFF + t * 128 + (w - 128)); }
    else sc0 = n0;
    const int c4 = lane & 15, kq = lane >> 4;
    const bool valid = (sc0 + 4 * c4) < Nsrc;
    f32x4 v[16];
#pragma unroll
    for (int i = 0; i < 16; ++i) {
        const int kk = kq + 4 * i;
        v[i] = valid ? __builtin_nontemporal_load((const f32x4*)(W + (size_t)(k0 + kk) * Nsrc + sc0 + 4 * c4)) : (f32x4){0.f, 0.f, 0.f, 0.f};
    }
#pragma unroll
    for (int i = 0; i < 16; ++i) {
        const int kk = kq + 4 * i; const float g = gain ? gain[k0 + kk] * scale : scale;
        float* d = scr + kk * 65 + 4 * c4;
        d[0] = v[i][0] * g; d[1] = v[i][1] * g; d[2] = v[i][2] * g; d[3] = v[i][3] * g;
    }
    LDS_FENCE();
    const int c = lane & 7;
#pragma unroll
    for (int j = 0; j < 8; ++j) {
        const int n = (lane >> 3) + 8 * j; const float* s = scr + (8 * c) * 65 + n;
        u32x4 o; o.x = pk2(s[0 * 65], s[1 * 65]); o.y = pk2(s[2 * 65], s[3 * 65]); o.z = pk2(s[4 * 65], s[5 * 65]); o.w = pk2(s[6 * 65], s[7 * 65]);
        *(u32x4*)(WT + (size_t)(n0 + n) * K + k0 + 8 * c) = o;
    }
    LDS_FENCE();
}

__device__ __forceinline__ void phase_prologue(ArgP a, unsigned char* smem, int wg, int G) {
    const int tid = ltid(), lane = tid & 63, wave = tid >> 6;
    const int gw = wg * NWAVES + wave, NGW = G * NWAVES;
    unsigned char* ws = a->ws;
    float* scr = (float*)(smem + wave * 16896);
    for (int mid = 0; mid < 26; ++mid) {
        const float* W; const float* gain = nullptr; bf16_t* WT; int K, Nsrc, Nd, mode = 0; float scale = 1.0f;
        if (mid < 16) {
            const int l = mid >> 2, k = mid & 3;
            if (k == 0)      { W = a->in[I_F1GU] + (size_t)l * DM * NGU; K = DM; Nsrc = NGU; Nd = NGU; gain = a->in[I_NF1] + l * DM; mode = 1; WT = w_gu(ws, l, 0); }
            else if (k == 1) { W = a->in[I_F1D] + (size_t)l * DFF * DM; K = DFF; Nsrc = DM; Nd = DM; scale = 0.5f; WT = w_dn(ws, l, 0); }
            else if (k == 2) { W = a->in[I_F2GU] + (size_t)l * DM * NGU; K = DM; Nsrc = NGU; Nd = NGU; gain = a->in[I_NF2] + l * DM; mode = 1; WT = w_gu(ws, l, 1); }
            else             { W = a->in[I_F2D] + (size_t)l * DFF * DM; K = DFF; Nsrc = DM; Nd = DM; scale = 0.5f; WT = w_dn(ws, l, 1); }
        } else if (mid < 22) {
            const int i = (mid - 16) / 3, k = (mid - 16) % 3;
            if (k == 0)      { W = a->in[I_ABIN] + (size_t)i * DM * NAB; K = DM; Nsrc = NAB; Nd = NAB; gain = a->in[I_NMIX] + (2 * i) * DM; WT = w_abin(ws, i); }
            else if (k == 1) { W = a->in[I_S5GLU] + (size_t)i * 512 * 512; K = 512; Nsrc = 512; Nd = 512; WT = w_glu(ws, i); }
            else             { W = a->in[I_ABOUT] + (size_t)i * DM * DM; K = DM; Nsrc = DM; Nd = DM; WT = w_about(ws, i); }
        } else {
            const int i = (mid - 22) >> 1, k = (mid - 22) & 1;
            if (k == 0)      { W = a->in[I_GIN] + (size_t)i * DM * NGLA; K = DM; Nsrc = NGLA; Nd = NGLAP; gain = a->in[I_NMIX] + (2 * i + 1) * DM; WT = w_gin(ws, i); }
            else             { W = a->in[I_GOUT] + (size_t)i * DM * DM; K = DM; Nsrc = DM; Nd = DM; WT = w_gout(ws, i); }
        }
        const int nblk = Nd / 64, nitems = (K / 64) * nblk;
        int start = gw - (mid * 601) % NGW; if (start < 0) start += NGW;
        for (int it = start; it < nitems; it += NGW) transpose_item(W, K, Nsrc, WT, gain, scale, mode, scr, it, nblk, lane);
    }
    bf16_t* __restrict__ XL = (bf16_t*)(ws + OFF_X); bf16_t* __restrict__ XB = (bf16_t*)(ws + OFF_XB); float* __restrict__ SS = (float*)(ws + OFF_SS);
#pragma unroll 4
    for (int m = gw; m < MPAD; m += NGW) {
        const float* src = nullptr;
        if (m < MP) { const int b = m / LP, t = m - b * LP; src = (t < NMETA) ? a->in[I_META] + (size_t)t * DM : a->in[I_XP] + ((size_t)b * 2048 + (t - NMETA)) * DM; }
        else if (m < MR) src = a->in[I_XS] + (size_t)(m - MP) * DM;
        float s = 0.f;
#pragma unroll
        for (int j = 0; j < 4; ++j) {
            f32x4 v = {0.f, 0.f, 0.f, 0.f};
            if (src) v = *((const f32x4*)src + 64 * j + lane);
            u32x2 w; w.x = pk2(v[0], v[1]); w.y = pk2(v[2], v[3]);
            u32x2 wl; wl.x = pk2(v[0] - blo(w.x), v[1] - bhi(w.x)); wl.y = pk2(v[2] - blo(w.y), v[3] - bhi(w.y));
            *((u32x2*)(XB + (size_t)m * DM) + 64 * j + lane) = w;
            if (RESID_LO) *((u32x2*)(XL + (size_t)m * DM) + 64 * j + lane) = wl;
            s += (v[0] * v[0] + v[1] * v[1]) + (v[2] * v[2] + v[3] * v[3]);
        }
        s = wave_sum(s);
        if (lane < 16) SS[(size_t)m * 16 + lane] = (lane == 0) ? s : 0.f;
    }
    {
        const int gt = wg * NTHR + tid, NT = G * NTHR;
        unsigned* pA = (unsigned*)(ws + OFF_A2 + (size_t)MR * DM * 2); unsigned* pZ = (unsigned*)(ws + OFF_Z + (size_t)MR * 512 * 2); unsigned* pO = (unsigned*)(ws + OFF_O + (size_t)MR * DM * 2);
        for (int i = gt; i < (MPAD - MR) * DM / 2; i += NT) { pA[i] = 0u; pO[i] = 0u; }
        for (int i = gt; i < (MPAD - MR) * 512 / 2; i += NT) pZ[i] = 0u;
        float* RC = (float*)(ws + OFF_ROT); float* RS = RC + NROT * 32;
        for (int i = gt; i < NROT * 32; i += NT) {
            const int idx = i >> 5, f = i & 31; const int pos = (idx < LP) ? idx : (16384 + idx - LP);
            const float inv = 1.0f / powf(10000.0f, (float)f / 32.0f);
            const float ang = (float)pos * inv;
            RC[i] = cosf(ang); RS[i] = sinf(ang);
        }
        for (int i = gt; i < 2 * 32 * 64; i += NT) {
            const int ev = i >> 11, gp = i & 2047, g = gp >> 6;
            float* Ta = (float*)(ws + OFF_S5T) + (size_t)ev * S5T_STRIDE_F; float* Tb = Ta + 32 * 64 * 2;
            const float ar = a->in[I_S5AR][i], ai = a->in[I_S5AI][i];
            const float dt = expf(a->in[I_S5DT][ev * 32 + g]);
            const float mag = expf(dt * ar);
            const float abr = mag * cosf(dt * ai), abi = mag * sinf(dt * ai);
            const float den = ar * ar + ai * ai, nre = abr - 1.0f;
            const float fre = (nre * ar + abi * ai) / den, fim = (abi * ar - nre * ai) / den;
            Ta[gp * 2] = abr; Ta[gp * 2 + 1] = abi;
            const float* br = a->in[I_S5BR] + (size_t)i * 16; const float* bi = a->in[I_S5BI] + (size_t)i * 16;
#pragma unroll
            for (int n = 0; n < 16; ++n) { Tb[gp * 32 + n] = fre * br[n] - fim * bi[n]; Tb[gp * 32 + 16 + n] = fre * bi[n] + fim * br[n]; }
        }
    }
}

typedef float f32x2 __attribute__((ext_vector_type(2)));
#define S5_STEP(t)                                                                                                            \
    { const f32x4 ua = *(const f32x4*)(Us + 16 * (t)), ub = *(const f32x4*)(Us + 16 * (t) + 4), uc = *(const f32x4*)(Us + 16 * (t) + 8), ud = *(const f32x4*)(Us + 16 * (t) + 12); \
      f32x2 xa = Bp[0] * ua[0], xb = Bp[4] * ub[0], xc = Bp[8] * uc[0], xd = Bp[12] * ud[0];       \
      xa = Bp[1] * ua[1] + xa; xb = Bp[5] * ub[1] + xb; xc = Bp[9] * uc[1] + xc; xd = Bp[13] * ud[1] + xd;                       \
      xa = Bp[2] * ua[2] + xa; xb = Bp[6] * ub[2] + xb; xc = Bp[10] * uc[2] + xc; xd = Bp[14] * ud[2] + xd;                      \
      xa = Bp[3] * ua[3] + xa; xb = Bp[7] * ub[3] + xb; xc = Bp[11] * uc[3] + xc; xd = Bp[15] * ud[3] + xd;                      \
      const f32x2 x2 = (xa + xb) + (xc + xd);                                                                                   \
                                         \
      const f32x2 hs = {-h2[1], h2[0]};                                                                                         \
      h2 = ab2[0] * h2 + (ab2[1] * hs + x2); }
constexpr int S5_WAVE_LDS = 16 * 136 * 2 + 16 * 16 * 4;

__device__ __forceinline__ void s5_pass1(ArgP a, int ev, unsigned char* smem, int gw, int NGW, int lane, int wave) {
    float* Us = (float*)(smem + wave * S5_WAVE_LDS + 16 * 136 * 2);
    unsigned char* ws = a->ws;
    const bf16_t* PROJ = (const bf16_t*)(ws + OFF_HP);
    const float* Ta = (const float*)(ws + OFF_S5T) + (size_t)ev * S5T_STRIDE_F; const float* Tb = Ta + 32 * 64 * 2;
    float* E = (float*)(ws + OFF_S5E);
    for (int item = gw; item < 8 * 32 * 16; item += NGW) {
        const int j = item & 15, g = (item >> 4) & 31, b = item >> 9;
        const float abr = Ta[(g * 64 + lane) * 2], abi = Ta[(g * 64 + lane) * 2 + 1];
        f32x2 Bp[16];
#pragma unroll
        for (int q = 0; q < 4; ++q) { const f32x4 vr = *((const f32x4*)(Tb + (size_t)(g * 64 + lane) * 32) + q), vi = *((const f32x4*)(Tb + (size_t)(g * 64 + lane) * 32) + 4 + q);
            Bp[4 * q] = (f32x2){vr[0], vi[0]}; Bp[4 * q + 1] = (f32x2){vr[1], vi[1]}; Bp[4 * q + 2] = (f32x2){vr[2], vi[2]}; Bp[4 * q + 3] = (f32x2){vr[3], vi[3]}; }
        const f32x2 ab2 = {abr, abi};
        f32x2 h2 = {0.f, 0.f};
        const bf16_t* up = PROJ + (size_t)(b * LP + j * 128) * NAB + 16 * g;
        u32x2 raw = *(const u32x2*)(up + (size_t)(lane >> 2) * NAB + 4 * (lane & 3));
        for (int blk = 0; blk < 8; ++blk) {
            LDS_FENCE();
            *(f32x4*)(Us + 4 * lane) = (f32x4){blo(raw.x), bhi(raw.x), blo(raw.y), bhi(raw.y)};
            LDS_FENCE();
            if (blk + 1 < 8) raw = *(const u32x2*)(up + (size_t)((blk + 1) * 16 + (lane >> 2)) * NAB + 4 * (lane & 3));
#pragma unroll
            for (int t = 0; t < 16; ++t) S5_STEP(t)
        }
        float* e = E + ((size_t)((b * 32 + g) * 16 + j)) * 128;
        e[lane] = h2[0]; e[64 + lane] = h2[1];
    }
}

__device__ __forceinline__ void s5_pass2(ArgP a, int ev, unsigned char* smem, int gw, int NGW, int lane, int wave) {
    unsigned char* ws = a->ws;
    const bf16_t* PROJ = (const bf16_t*)(ws + OFF_HP);
    bf16_t* Z = (bf16_t*)(ws + OFF_Z);
    const float* Ta = (const float*)(ws + OFF_S5T) + (size_t)ev * S5T_STRIDE_F; const float* Tb = Ta + 32 * 64 * 2;
    const float* E = (const float*)(ws + OFF_S5E);
    bf16_t* Hs = (bf16_t*)(smem + wave * S5_WAVE_LDS);
    float* Us = (float*)(smem + wave * S5_WAVE_LDS + 16 * 136 * 2);
    const int fr = lane & 15, fq = lane >> 4;
    constexpr int NPI = 8 * 32 * 17, NSI = 128 * 32;
    for (int item = gw; item < NPI + NSI; item += NGW) {
        int b, g, j, nblk, nvalid; size_t row0; bool prompt = item < NPI;
        if (prompt) { int bg; if (item < 4096) { j = item & 15; bg = item >> 4; } else { j = 16; bg = item - 4096; }
            g = bg & 31; b = bg >> 5; nblk = (j < 16) ? 8 : 1; nvalid = 16; row0 = (size_t)b * LP + j * 128; }
        else { const int it = item - NPI; g = it & 31; b = it >> 5; j = 0; nblk = 1; nvalid = 8; row0 = (size_t)MP + b * 8; }
        const float abr = Ta[(g * 64 + lane) * 2], abi = Ta[(g * 64 + lane) * 2 + 1];
        f32x2 Bp[16];
#pragma unroll
        for (int q = 0; q < 4; ++q) { const f32x4 vr = *((const f32x4*)(Tb + (size_t)(g * 64 + lane) * 32) + q), vi = *((const f32x4*)(Tb + (size_t)(g * 64 + lane) * 32) + 4 + q);
            Bp[4 * q] = (f32x2){vr[0], vi[0]}; Bp[4 * q + 1] = (f32x2){vr[1], vi[1]}; Bp[4 * q + 2] = (f32x2){vr[2], vi[2]}; Bp[4 * q + 3] = (f32x2){vr[3], vi[3]}; }
        const f32x2 ab2 = {abr, abi};
        bf16x8 Cf[4];
        {
            const float* cr = a->in[I_S5CR] + ((size_t)(ev * 32 + g) * 16 + fr) * 64; const float* ci = a->in[I_S5CI] + ((size_t)(ev * 32 + g) * 16 + fr) * 64;
#pragma unroll
            for (int kb = 0; kb < 4; ++kb) {
                const float* p = (kb < 2) ? (cr + 32 * kb + 8 * fq) : (ci + 32 * (kb - 2) + 8 * fq); const float sg = (kb < 2) ? 1.f : -1.f;
                const f32x4 v0 = *(const f32x4*)p, v1 = *(const f32x4*)(p + 4);
                u32x4 w; w.x = pk2(sg * v0[0], sg * v0[1]); w.y = pk2(sg * v0[2], sg * v0[3]); w.z = pk2(sg * v1[0], sg * v1[1]); w.w = pk2(sg * v1[2], sg * v1[3]);
                Cf[kb] = __builtin_bit_cast(bf16x8, w);
            }
        }
        const float dsk = a->in[I_S5D][ev * 512 + 16 * g + fr];
        float hr = 0.f, hi = 0.f;
        if (prompt) {
            float pr = abr, pi = abi;
#pragma unroll
            for (int s = 0; s < 7; ++s) { const float tr = pr * pr - pi * pi, ti = 2.f * pr * pi; pr = tr; pi = ti; }
            const float* e = E + ((size_t)((b * 32 + g) * 16)) * 128;
            float er[16], ei[16];
#pragma unroll
            for (int jj = 0; jj < 16; ++jj) { er[jj] = 0.f; ei[jj] = 0.f; if (jj < j) { er[jj] = e[jj * 128 + lane]; ei[jj] = e[jj * 128 + 64 + lane]; } }
#pragma unroll
            for (int jj = 0; jj < 16; ++jj) if (jj < j) { const float nr = pr * hr - pi * hi + er[jj], ni = pr * hi + pi * hr + ei[jj]; hr = nr; hi = ni; }
        } else {
            hr = a->in[I_S5R][((size_t)(ev * 128 + b) * 32 + g) * 64 + lane]; hi = a->in[I_S5I][((size_t)(ev * 128 + b) * 32 + g) * 64 + lane];
        }
        float fhr = 0.f, fhi = 0.f;
        f32x2 h2 = {hr, hi};
        const int tl = lane >> 2;
        u32x2 raw = {0u, 0u};
        if (tl < nvalid) raw = *(const u32x2*)(PROJ + (row0 + tl) * NAB + 16 * g + 4 * (lane & 3));
        for (int blk = 0; blk < nblk; ++blk) {
            const size_t rb = row0 + blk * 16;
            *(f32x4*)(Us + 4 * lane) = (f32x4){blo(raw.x), bhi(raw.x), blo(raw.y), bhi(raw.y)};
            LDS_FENCE();
            if (blk + 1 < nblk) raw = *(const u32x2*)(PROJ + (rb + 16 + tl) * NAB + 16 * g + 4 * (lane & 3));
#pragma unroll
            for (int t = 0; t < 16; ++t) {
                S5_STEP(t)
                const unsigned hb = pg8::cvt_pk_bf16(h2[0], h2[1]);
                Hs[t * 136 + lane] = (bf16_t)(hb & 0xffffu); Hs[t * 136 + 64 + lane] = (bf16_t)(hb >> 16);
                if (t == 7) { fhr = h2[0]; fhi = h2[1]; }
            }
            LDS_FENCE();
            f32x4 acc = {0.f, 0.f, 0.f, 0.f};
#pragma unroll
            for (int kb = 0; kb < 4; ++kb) {
                const bf16x8 af = *(const bf16x8*)(Hs + fr * 136 + 32 * kb + 8 * fq);
                acc = __builtin_amdgcn_mfma_f32_16x16x32_bf16(af, Cf[kb], acc, 0, 0, 0);
            }
            LDS_FENCE();
#pragma unroll
            for (int e = 0; e < 4; ++e) {
                const int t = 4 * fq + e;
                if (t < nvalid) {
                    const float uv = Us[16 * t + fr];
                    const float y = acc[e] + dsk * uv;
                    Z[(rb + t) * 512 + 16 * g + fr] = f2bf(gelu_tanh(y));
                }
            }
        }
        if (prompt) {
            if (j == 16) { a->out[OUT_PS5R + ((size_t)(ev * 8 + b) * 32 + g) * 64 + lane] = h2[0]; a->out[OUT_PS5I + ((size_t)(ev * 8 + b) * 32 + g) * 64 + lane] = h2[1]; }
        } else {
            a->out[OUT_SS5R + ((size_t)(ev * 128 + b) * 32 + g) * 64 + lane] = fhr; a->out[OUT_SS5I + ((size_t)(ev * 128 + b) * 32 + g) * 64 + lane] = fhi;
        }
    }
}

constexpr int NCH = 33, NPITEM = NB * 4 * NCH;
template <int DK> __device__ __forceinline__ bf16_t* prep_q(unsigned char* ws, int item) { return (bf16_t*)(ws + OFF_A2) + (size_t)item * 64 * DK; }
template <int DK> __device__ __forceinline__ bf16_t* prep_k(unsigned char* ws, int item) { return (bf16_t*)(ws + OFF_A2) + (size_t)NPITEM * 64 * DK + (size_t)item * 64 * DK; }
__device__ __forceinline__ bf16_t* prep_p(unsigned char* ws, int item) { return (bf16_t*)(ws + OFF_PART) + (size_t)item * 64 * 64; }
__device__ __forceinline__ float* prep_a(unsigned char* ws, int item) { return (float*)(ws + OFF_S5E) + (size_t)item * 128; }

template <int DK, bool GLA>
__device__ __forceinline__ void la_prep(ArgP a, int li, unsigned char* smem, int wg, int G) {
    constexpr int C = 64, LDQ = DK + 8, LDT = C + 8, LDP = GLA ? NGLAP : NAB;
    unsigned char* ws = a->ws;
    const bf16_t* PROJ = (const bf16_t*)(ws + OFF_HP);
    bf16_t* Qt = (bf16_t*)smem;
    bf16_t* Kt = Qt + C * LDQ;
    bf16_t* KhT = Kt + C * LDQ;
    bf16_t* Pb = KhT + DK * LDT;
    float* aS = (float*)(Pb + C * LDT);
    float* Bc = aS + DK;
    float* LR = Bc + (GLA ? C * DK : 0);
    const int tid = ltid(), lane = tid & 63, w = tid >> 6, fr = lane & 15, fq = lane >> 4;
    const float* RC = (const float*)(ws + OFF_ROT); const float* RS = RC + NROT * 32;
    for (int item = wg; item < NPITEM; item += G) {
        const int c = item % NCH, h = (item / NCH) & 3, b = item / (NCH * 4);
        const size_t rowc = (size_t)b * LP + 64 * c;
        const int nv = (c < 32) ? 64 : 16;
        __syncthreads();
        if constexpr (GLA) {
            const int grp = tid >> 7, d = tid & 127;
            float wa[16];
#pragma unroll
            for (int n = 0; n < 16; ++n) wa[n] = a->in[I_GA2][((size_t)li * 16 + n) * 512 + h * 128 + d];
            const float bias = a->in[I_GBA][li * 512 + h * 128 + d];
#pragma unroll
            for (int r = 0; r < 2; ++r) { const int e = tid + r * 512, t = e >> 4, n = e & 15; LR[e] = (t < nv) ? bf2f(PROJ[(rowc + t) * LDP + 3072 + n]) : 0.f; }
            float qv[16], kv[16];
#pragma unroll
            for (int tl = 0; tl < 16; ++tl) {
                const int t = 16 * grp + tl; qv[tl] = 0.f; kv[tl] = 0.f;
                if (t < nv) { qv[tl] = bf2f(PROJ[(rowc + t) * LDP + 128 * h + d]); kv[tl] = bf2f(PROJ[(rowc + t) * LDP + 512 + 128 * h + d]) * 0.08838834764831845f; }
            }
            __syncthreads();
            float bl[16];
            {
                float cum = 0.f;
#pragma unroll
                for (int tl = 0; tl < 16; ++tl) {
                    const int t = 16 * grp + tl; float x = bias;
#pragma unroll
                    for (int n = 0; n < 16; ++n) x = fmaf(LR[t * 16 + n], wa[n], x);
                    const float la = (t < nv) ? logsig(x) * (1.0f / 16.0f) : 0.f;
                    cum += la; bl[tl] = cum;
                }
                Bc[grp * DK + d] = cum;
            }
            __syncthreads();
            {
                float off = 0.f, blast = 0.f;
#pragma unroll
                for (int gg = 0; gg < 4; ++gg) { const float v = Bc[gg * DK + d]; blast += v; if (gg < grp) off += v; }
#pragma unroll
                for (int tl = 0; tl < 16; ++tl) {
                    const int t = 16 * grp + tl; const float bb = bl[tl] + off;
                    Qt[t * LDQ + d] = f2bf(qv[tl] * __expf(bb)); Kt[t * LDQ + d] = f2bf(kv[tl] * __expf(-bb)); KhT[d * LDT + t] = f2bf(kv[tl] * __expf(blast - bb));
                }
                if (grp == 0) aS[d] = __expf(blast);
            }
        } else {
            const float lg = logf(1.0f - exp2f(-5.0f - (float)h));
            const int t = tid >> 3, dg = tid & 7; const int pos = 64 * c + t;
            u32x2 ql = {0u, 0u}, qh = {0u, 0u}, kl = {0u, 0u}, kh = {0u, 0u};
            f32x4 cs = {1.f, 1.f, 1.f, 1.f}, sn = {0.f, 0.f, 0.f, 0.f};
            if (t < nv) {
                const bf16_t* pr = PROJ + (rowc + t) * LDP;
                ql = *(const u32x2*)(pr + 512 + 64 * h + 4 * dg); qh = *(const u32x2*)(pr + 512 + 64 * h + 32 + 4 * dg);
                kl = *(const u32x2*)(pr + 768 + 64 * h + 4 * dg); kh = *(const u32x2*)(pr + 768 + 64 * h + 32 + 4 * dg);
                cs = *(const f32x4*)(RC + (size_t)pos * 32 + 4 * dg); sn = *(const f32x4*)(RS + (size_t)pos * 32 + 4 * dg);
            }
            const int te = (t < nv) ? (t + 1) : nv;
            const float bt = (float)te * lg, blast = (float)nv * lg;
            const float eq = __expf(bt), ek = 0.125f * __expf(-bt), ekh = 0.125f * __expf(blast - bt);
            const float q1[4] = {blo(ql.x), bhi(ql.x), blo(ql.y), bhi(ql.y)}, q2[4] = {blo(qh.x), bhi(qh.x), blo(qh.y), bhi(qh.y)};
            const float k1[4] = {blo(kl.x), bhi(kl.x), blo(kl.y), bhi(kl.y)}, k2[4] = {blo(kh.x), bhi(kh.x), blo(kh.y), bhi(kh.y)};
#pragma unroll
            for (int x = 0; x < 4; ++x) {
                const int d = 4 * dg + x;
                const float qa = q1[x] * cs[x] - q2[x] * sn[x], qb = q1[x] * sn[x] + q2[x] * cs[x];
                const float ka = k1[x] * cs[x] - k2[x] * sn[x], kb = k1[x] * sn[x] + k2[x] * cs[x];
                Qt[t * LDQ + d] = f2bf(qa * eq); Qt[t * LDQ + d + 32] = f2bf(qb * eq);
                Kt[t * LDQ + d] = f2bf(ka * ek); Kt[t * LDQ + d + 32] = f2bf(kb * ek);
                KhT[d * LDT + t] = f2bf(ka * ekh); KhT[(d + 32) * LDT + t] = f2bf(kb * ekh);
            }
        }
        __syncthreads();
        {
            const int ptt = w >> 1;
#pragma unroll
            for (int s2 = 0; s2 < 2; ++s2) {
                const int st = 2 * (w & 1) + s2;
                f32x4 p = {0.f, 0.f, 0.f, 0.f};
                if (st <= ptt) {
#pragma unroll
                    for (int kb = 0; kb < DK / 32; ++kb) {
                        const bf16x8 af = *(const bf16x8*)(Qt + (16 * ptt + fr) * LDQ + 32 * kb + 8 * fq);
                        const bf16x8 bfg = *(const bf16x8*)(Kt + (16 * st + fr) * LDQ + 32 * kb + 8 * fq);
                        p = __builtin_amdgcn_mfma_f32_16x16x32_bf16(af, bfg, p, 0, 0, 0);
                    }
                }
#pragma unroll
                for (int e = 0; e < 4; ++e) { const int t = 16 * ptt + 4 * fq + e, s = 16 * st + fr; Pb[t * LDT + s] = (s <= t) ? f2bf(p[e]) : (bf16_t)0; }
            }
        }
        __syncthreads();
        bf16_t* qg = prep_q<DK>(ws, item); bf16_t* kg = prep_k<DK>(ws, item); bf16_t* pg = prep_p(ws, item);
#pragma unroll
        for (int r = 0; r < DK / 64; ++r) {
            const int e = tid + r * 512;
            { const int t = e / (DK / 8), cc = e % (DK / 8); *(u32x4*)(qg + t * DK + 8 * cc) = *(const u32x4*)(Qt + t * LDQ + 8 * cc); }
            { const int d = e >> 3, cc = e & 7; *(u32x4*)(kg + d * 64 + 8 * cc) = *(const u32x4*)(KhT + d * LDT + 8 * cc); }
        }
        { const int t = tid >> 3, cc = tid & 7; *(u32x4*)(pg + t * 64 + 8 * cc) = *(const u32x4*)(Pb + t * LDT + 8 * cc); }
        if constexpr (GLA) { if (tid < DK) prep_a(ws, item)[tid] = aS[tid]; }
    }
}

template <int DK, int DV, int DVS, bool GLA>
__device__ __forceinline__ void la_prompt(ArgP a, int li, unsigned char* smem, int wg, int G) {
    constexpr int C = 64, NSL = DV / DVS, NTM = DVS / 16, NTN = DK / 16, LDQ = DK + 8, LDT = C + 8, LDP = GLA ? NGLAP : NAB, LDO = 4 * DV, NR = DK / 64;
    static_assert(NTM == 1 || NTM == 2, "dv tiles per slice");
    unsigned char* ws = a->ws;
    const bf16_t* PROJ = (const bf16_t*)(ws + OFF_HP);
    bf16_t* OB = (bf16_t*)(ws + OFF_O);
    constexpr int BUF_ELEMS = C * LDQ + DK * LDT + DVS * LDT + C * LDT + DVS * LDQ + 2 * DK;
    static_assert((BUF_ELEMS * 2) % 16 == 0 && 2 * BUF_ELEMS * 2 <= RING_BYTES, "la_prompt LDS");
    const int tid = ltid(), lane = tid & 63, w = tid >> 6, fr = lane & 15, fq = lane >> 4;
    const int tt = (NTM == 2) ? (w >> 1) : (w & 3), dt = (NTM == 2) ? (w & 1) : 0;
    const bool has_o = (NTM == 2) || (w < 4);
    const bool has_v = GLA || (tid < 256);
    const int vt = GLA ? (tid >> 3) : (tid >> 2), vj4 = GLA ? ((tid & 7) * 4) : ((tid & 3) * 4);
    for (int item0 = wg; item0 < NB * 4 * NSL; item0 += G) {
        const int item = (G == NB * 4 * NSL && (G & 7) == 0) ? (item0 & 7) * (G >> 3) + (item0 >> 3) : item0;
        const int sl = item % NSL, h = (item / NSL) & 3, b = item / (NSL * 4);
        const int pit0 = (b * 4 + h) * NCH;
        const float lg = GLA ? 0.f : logf(1.0f - exp2f(-5.0f - (float)h));
        f32x4 sacc[NTM];
#pragma unroll
        for (int m = 0; m < NTM; ++m) sacc[m] = (f32x4){0.f, 0.f, 0.f, 0.f};
        u32x4 rq0[NR], rk0[NR], rp0, rq1[NR], rk1[NR], rp1; u32x2 rv0 = {0u, 0u}, rv1 = {0u, 0u}; float ra0 = 0.f, ra1 = 0.f;
#define LA_PREFETCH(S_, cc_) do { const int c_ = (cc_); const int nv_ = (c_ < 32) ? 64 : 16; const size_t rowc_ = (size_t)b * LP + 64 * c_; \
            const bf16_t* qg = prep_q<DK>(ws, pit0 + c_); const bf16_t* kg = prep_k<DK>(ws, pit0 + c_); const bf16_t* pg = prep_p(ws, pit0 + c_); \
            _Pragma("unroll") for (int r = 0; r < NR; ++r) { rq##S_[r] = *(const u32x4*)(qg + (size_t)(tid + r * 512) * 8); rk##S_[r] = *(const u32x4*)(kg + (size_t)(tid + r * 512) * 8); } \
            rp##S_ = *(const u32x4*)(pg + (size_t)tid * 8); \
            if (GLA) { if (tid < DK) ra##S_ = prep_a(ws, pit0 + c_)[tid]; } else ra##S_ = __expf((float)nv_ * lg); \
            rv##S_ = (u32x2){0u, 0u}; if (has_v && vt < nv_) rv##S_ = *(const u32x2*)(PROJ + (rowc_ + vt) * LDP + 1024 + DV * h + DVS * sl + vj4); } while (0)
#define LA_BUF(par_) bf16_t* Qt = (bf16_t*)smem + (par_) * BUF_ELEMS; bf16_t* KhT = Qt + C * LDQ; bf16_t* VT = KhT + DK * LDT; bf16_t* Pb = VT + DVS * LDT; bf16_t* ST = Pb + C * LDT; float* aS = (float*)(ST + DVS * LDQ);
#define LA_STAGE(S_, par_) do { LA_BUF(par_) (void)ST; \
            _Pragma("unroll") for (int r = 0; r < NR; ++r) { const int e = tid + r * 512; \
                { const int t = e / (DK / 8), cc = e % (DK / 8); *(u32x4*)(Qt + t * LDQ + 8 * cc) = rq##S_[r]; } \
                { const int d = e >> 3, cc = e & 7; *(u32x4*)(KhT + d * LDT + 8 * cc) = rk##S_[r]; } } \
            { const int t = tid >> 3, cc = tid & 7; *(u32x4*)(Pb + t * LDT + 8 * cc) = rp##S_; } \
            if (tid < DK) aS[tid] = ra##S_; \
            if (has_v) { VT[(vj4 + 0) * LDT + vt] = (bf16_t)(rv##S_.x & 0xffffu); VT[(vj4 + 1) * LDT + vt] = (bf16_t)(rv##S_.x >> 16); \
                         VT[(vj4 + 2) * LDT + vt] = (bf16_t)(rv##S_.y & 0xffffu); VT[(vj4 + 3) * LDT + vt] = (bf16_t)(rv##S_.y >> 16); } } while (0)
#define LA_CHUNK(S_, c_expr) do { const int c = (c_expr); const size_t rowc = (size_t)b * LP + 64 * c; const int nv = (c < 32) ? 64 : 16; \
            __syncthreads(); \
            if (c + 1 < NCH) LA_STAGE(S_, (c + 1) & 1); \
            if (c + 3 < NCH) LA_PREFETCH(S_, c + 3); \
            LA_BUF(c & 1) \
            if (has_o) { \
                f32x4 o = {0.f, 0.f, 0.f, 0.f}; \
                _Pragma("unroll") for (int kb = 0; kb < DK / 32; ++kb) { \
                    const bf16x8 af = *(const bf16x8*)(Qt + (16 * tt + fr) * LDQ + 32 * kb + 8 * fq); \
                    const bf16x8 bfg = *(const bf16x8*)(ST + (16 * dt + fr) * LDQ + 32 * kb + 8 * fq); \
                    o = __builtin_amdgcn_mfma_f32_16x16x32_bf16(af, bfg, o, 0, 0, 0); } \
                _Pragma("unroll") for (int kb = 0; kb < 2; ++kb) { \
                    const bf16x8 af = *(const bf16x8*)(Pb + (16 * tt + fr) * LDT + 32 * kb + 8 * fq); \
                    const bf16x8 bfg = *(const bf16x8*)(VT + (16 * dt + fr) * LDT + 32 * kb + 8 * fq); \
                    o = __builtin_amdgcn_mfma_f32_16x16x32_bf16(af, bfg, o, 0, 0, 0); } \
                _Pragma("unroll") for (int e = 0; e < 4; ++e) { const int t = 16 * tt + 4 * fq + e; if (t < nv) OB[(rowc + t) * LDO + h * DV + DVS * sl + 16 * dt + fr] = f2bf(o[e]); } \
            } \
            if (w < NTN) { \
                const float av = aS[16 * w + fr]; \
                bf16_t* STn = (bf16_t*)smem + ((c + 1) & 1) * BUF_ELEMS + C * LDQ + DK * LDT + DVS * LDT + C * LDT; \
                _Pragma("unroll") for (int m = 0; m < NTM; ++m) { \
                    f32x4 s_ = sacc[m] * av; \
                    _Pragma("unroll") for (int kb = 0; kb < 2; ++kb) { \
                        const bf16x8 af = *(const bf16x8*)(VT + (16 * m + fr) * LDT + 32 * kb + 8 * fq); \
                        const bf16x8 bfg = *(const bf16x8*)(KhT + (16 * w + fr) * LDT + 32 * kb + 8 * fq); \
                        s_ = __builtin_amdgcn_mfma_f32_16x16x32_bf16(af, bfg, s_, 0, 0, 0); } \
                    sacc[m] = s_; \
                    _Pragma("unroll") for (int e = 0; e < 4; ++e) STn[(16 * m + 4 * fq + e) * LDQ + 16 * w + fr] = f2bf(s_[e]); } \
            } } while (0)
        __syncthreads();
        LA_PREFETCH(0, 0);
        LA_STAGE(0, 0);
        { LA_BUF(0) (void)Qt; (void)KhT; (void)VT; (void)Pb; (void)aS;
          if (w < NTN) {
#pragma unroll
              for (int m = 0; m < NTM; ++m)
#pragma unroll
                  for (int e = 0; e < 4; ++e) ST[(16 * m + 4 * fq + e) * LDQ + 16 * w + fr] = (bf16_t)0;
          } }
        LA_PREFETCH(1, 1);
        LA_PREFETCH(0, 2);
        for (int c2 = 0; c2 < NCH; c2 += 2) {
            LA_CHUNK(1, c2);
            if (c2 + 1 < NCH) LA_CHUNK(0, c2 + 1);
        }
#undef LA_CHUNK
#undef LA_BUF
#undef LA_STAGE
#undef LA_PREFETCH
        if (w < NTN) {
            float* so = a->out + (GLA ? OUT_PGLA : OUT_PRET) + (((size_t)(li * NB + b) * 4 + h) * DK + 16 * w + fr) * DV + DVS * sl;
#pragma unroll
            for (int m = 0; m < NTM; ++m) __builtin_nontemporal_store(sacc[m], (f32x4*)(so + 16 * m + 4 * fq));
        }
    }
}

template <int DK, int DV, bool GLA>
__device__ __forceinline__ void la_sample(ArgP a, int li, unsigned char* smem, int wg, int G) {
    constexpr int NJ4 = DV / 4, NG = NTHR / NJ4, RPG = DK / NG, LDP = GLA ? NGLAP : NAB, LDO = 4 * DV;
    unsigned char* ws = a->ws;
    const bf16_t* PROJ = (const bf16_t*)(ws + OFF_HP);
    bf16_t* OB = (bf16_t*)(ws + OFF_O);
    float* QK = (float*)smem;
    float* Kts = QK + DK * 16;
    float* Qts = Kts + 8 * DK;
    float* As = Qts + 8 * DK;
    float* Vs = As + DK;
    float* Ps = Vs + 8 * DV;
    float* Ored = Ps + 64;
    float* LR = Ored + NG * 8 * DV;
    const int tid = ltid();
    const float* RC = (const float*)(ws + OFF_ROT); const float* RS = RC + NROT * 32;
    const float* S0base = a->in[GLA ? I_SGLA : I_SRET]; float* S1base = a->out + (GLA ? OUT_SGLA : OUT_SRET);
    for (int item = wg; item < NSB * 4; item += G) {
        const int b = item >> 2, h = item & 3;
        const size_t row0 = (size_t)MP + b * 8;
        __syncthreads();
        for (int e = tid; e < 8 * DV; e += NTHR) { const int t = e / DV, j = e % DV; Vs[e] = bf2f(PROJ[(row0 + t) * LDP + 1024 + h * DV + j]); }
        if constexpr (GLA) {
            if (tid < 128) LR[tid] = bf2f(PROJ[(row0 + (tid >> 4)) * LDP + 3072 + (tid & 15)]);
            __syncthreads();
            if (tid < DK) {
                const int d = tid; float bt[8]; float cum = 0.f;
                const float bias = a->in[I_GBA][li * 512 + h * 128 + d];
                float wa[16];
#pragma unroll
                for (int n = 0; n < 16; ++n) wa[n] = a->in[I_GA2][((size_t)li * 16 + n) * 512 + h * 128 + d];
#pragma unroll
                for (int t = 0; t < 8; ++t) {
                    float x = bias;
#pragma unroll
                    for (int n = 0; n < 16; ++n) x = fmaf(LR[t * 16 + n], wa[n], x);
                    cum += logsig(x) * (1.0f / 16.0f); bt[t] = cum;
                }
#pragma unroll
                for (int t = 0; t < 8; ++t) {
                    const float q = bf2f(PROJ[(row0 + t) * LDP + 128 * h + d]);
                    const float k = bf2f(PROJ[(row0 + t) * LDP + 512 + 128 * h + d]) * 0.08838834764831845f;
                    const float qt = q * __expf(bt[t]);
                    QK[d * 16 + t] = qt; QK[d * 16 + 8 + t] = k * __expf(bt[7] - bt[t]); Kts[t * DK + d] = k * __expf(-bt[t]); Qts[t * DK + d] = qt;
                }
                As[d] = __expf(bt[7]);
            }
        } else {
            if (tid < 256) {
                const int t = tid >> 5, d = tid & 31;
                const float lg = logf(1.0f - exp2f(-5.0f - (float)h));
                const bf16_t* pr = PROJ + (row0 + t) * LDP;
                const float q1 = bf2f(pr[512 + 64 * h + d]), q2 = bf2f(pr[512 + 64 * h + 32 + d]), k1 = bf2f(pr[768 + 64 * h + d]), k2 = bf2f(pr[768 + 64 * h + 32 + d]);
                const float cs = RC[(size_t)(LP + t) * 32 + d], sn = RS[(size_t)(LP + t) * 32 + d];
                const float qa = q1 * cs - q2 * sn, qb = q1 * sn + q2 * cs, ka = k1 * cs - k2 * sn, kb = k1 * sn + k2 * cs;
                const float bt = (float)(t + 1) * lg;
                const float eq = __expf(bt), ek = 0.125f * __expf(-bt), ekh = 0.125f * __expf(8.0f * lg - bt);
                QK[d * 16 + t] = qa * eq; QK[(d + 32) * 16 + t] = qb * eq; QK[d * 16 + 8 + t] = ka * ekh; QK[(d + 32) * 16 + 8 + t] = kb * ekh;
                Kts[t * DK + d] = ka * ek; Kts[t * DK + d + 32] = kb * ek; Qts[t * DK + d] = qa * eq; Qts[t * DK + d + 32] = qb * eq;
                if (tid < DK) As[tid] = __expf(8.0f * lg);
            }
        }
        __syncthreads();
        if (tid < 64) {
            const int t = tid >> 3, s = tid & 7; float p = 0.f;
            if (s <= t) { for (int d = 0; d < DK; ++d) p = fmaf(Qts[t * DK + d], Kts[s * DK + d], p); }
            Ps[tid] = p;
        }
        const int grp = tid / NJ4, j4 = (tid % NJ4) * 4;
        const float* S0 = S0base + ((size_t)(li * NSB + b) * 4 + h) * DK * DV; float* S1 = S1base + ((size_t)(li * NSB + b) * 4 + h) * DK * DV;
        f32x4 s0[RPG];
#pragma unroll
        for (int ii = 0; ii < RPG; ++ii) s0[ii] = __builtin_nontemporal_load((const f32x4*)(S0 + (size_t)(grp * RPG + ii) * DV + j4));
        f32x4 vj[8], oa[8];
#pragma unroll
        for (int s2 = 0; s2 < 8; ++s2) { vj[s2] = *(const f32x4*)(Vs + s2 * DV + j4); oa[s2] = (f32x4){0.f, 0.f, 0.f, 0.f}; }
#pragma unroll
        for (int ii = 0; ii < RPG; ++ii) {
            const int i = grp * RPG + ii;
            const f32x4 qa = *(const f32x4*)(QK + i * 16), qb = *(const f32x4*)(QK + i * 16 + 4), ka = *(const f32x4*)(QK + i * 16 + 8), kb = *(const f32x4*)(QK + i * 16 + 12);
            const f32x4 sv = s0[ii];
            oa[0] = sv * qa[0] + oa[0]; oa[1] = sv * qa[1] + oa[1]; oa[2] = sv * qa[2] + oa[2]; oa[3] = sv * qa[3] + oa[3];
            oa[4] = sv * qb[0] + oa[4]; oa[5] = sv * qb[1] + oa[5]; oa[6] = sv * qb[2] + oa[6]; oa[7] = sv * qb[3] + oa[7];
            f32x4 sn = sv * As[i];
            sn = vj[0] * ka[0] + sn; sn = vj[1] * ka[1] + sn; sn = vj[2] * ka[2] + sn; sn = vj[3] * ka[3] + sn;
            sn = vj[4] * kb[0] + sn; sn = vj[5] * kb[1] + sn; sn = vj[6] * kb[2] + sn; sn = vj[7] * kb[3] + sn;
            __builtin_nontemporal_store(sn, (f32x4*)(S1 + (size_t)i * DV + j4));
        }
#pragma unroll
        for (int t = 0; t < 8; ++t) *(f32x4*)(Ored + (grp * 8 + t) * DV + j4) = oa[t];
        __syncthreads();
        for (int e = tid; e < 8 * NJ4; e += NTHR) {
            const int t = e / NJ4, jj = (e % NJ4) * 4; f32x4 o = {0.f, 0.f, 0.f, 0.f};
#pragma unroll
            for (int g2 = 0; g2 < NG; ++g2) o = o + *(const f32x4*)(Ored + (g2 * 8 + t) * DV + jj);
#pragma unroll
            for (int s2 = 0; s2 < 8; ++s2) o = *(const f32x4*)(Vs + s2 * DV + jj) * Ps[t * 8 + s2] + o;
            u32x2 wv; wv.x = pk2(o[0], o[1]); wv.y = pk2(o[2], o[3]);
            *(u32x2*)(OB + (row0 + t) * LDO + h * DV + jj) = wv;
        }
    }
}

__device__ __forceinline__ void ret_finalize(ArgP a, int gw, int NGW, int lane) {
    unsigned char* ws = a->ws;
    const bf16_t* __restrict__ PROJ = (const bf16_t*)(ws + OFF_HP); const bf16_t* __restrict__ OB = (const bf16_t*)(ws + OFF_O); bf16_t* __restrict__ A2 = (bf16_t*)(ws + OFF_A2);
#pragma unroll 4
    for (int m = gw; m < MR; m += NGW) {
        const u32x4 ow = *((const u32x4*)(OB + (size_t)m * 512) + lane);
        const u32x4 gwd = *((const u32x4*)(PROJ + (size_t)m * NAB + 1536) + lane);
        float o[8] = {blo(ow.x), bhi(ow.x), blo(ow.y), bhi(ow.y), blo(ow.z), bhi(ow.z), blo(ow.w), bhi(ow.w)};
        float g[8] = {blo(gwd.x), bhi(gwd.x), blo(gwd.y), bhi(gwd.y), blo(gwd.z), bhi(gwd.z), blo(gwd.w), bhi(gwd.w)};
        float s = 0.f;
#pragma unroll
        for (int i = 0; i < 8; ++i) s += o[i];
        s += __shfl_xor(s, 1); s += __shfl_xor(s, 2); s += __shfl_xor(s, 4); s += __shfl_xor(s, 8);
        const float mu = s * (1.0f / 128.0f); float q = 0.f;
#pragma unroll
        for (int i = 0; i < 8; ++i) { o[i] -= mu; q += o[i] * o[i]; }
        q += __shfl_xor(q, 1); q += __shfl_xor(q, 2); q += __shfl_xor(q, 4); q += __shfl_xor(q, 8);
        const float rs = rsqrtf(q * (1.0f / 128.0f) + 1e-6f);
        u32x4 w;
        w.x = pk2(o[0] * rs * silu(g[0]), o[1] * rs * silu(g[1])); w.y = pk2(o[2] * rs * silu(g[2]), o[3] * rs * silu(g[3]));
        w.z = pk2(o[4] * rs * silu(g[4]), o[5] * rs * silu(g[5])); w.w = pk2(o[6] * rs * silu(g[6]), o[7] * rs * silu(g[7]));
        *((u32x4*)(A2 + (size_t)m * DM + 512) + lane) = w;
    }
}
__device__ __forceinline__ void gla_finalize(ArgP a, int li, int gw, int NGW, int lane) {
    unsigned char* ws = a->ws;
    const bf16_t* __restrict__ PROJ = (const bf16_t*)(ws + OFF_HP); const bf16_t* __restrict__ OB = (const bf16_t*)(ws + OFF_O); bf16_t* __restrict__ A2 = (bf16_t*)(ws + OFF_A2);
    const float* ng = a->in[I_GNORM] + li * 256 + 16 * (lane & 15);
    float gn[16];
#pragma unroll
    for (int i = 0; i < 16; ++i) gn[i] = ng[i];
#pragma unroll 4
    for (int m = gw; m < MR; m += NGW) {
        const u32x4 o0 = *((const u32x4*)(OB + (size_t)m * DM) + 2 * lane), o1 = *((const u32x4*)(OB + (size_t)m * DM) + 2 * lane + 1);
        const u32x4 r0 = *((const u32x4*)(PROJ + (size_t)m * NGLAP + 2048) + 2 * lane), r1 = *((const u32x4*)(PROJ + (size_t)m * NGLAP + 2048) + 2 * lane + 1);
        float o[16] = {blo(o0.x), bhi(o0.x), blo(o0.y), bhi(o0.y), blo(o0.z), bhi(o0.z), blo(o0.w), bhi(o0.w), blo(o1.x), bhi(o1.x), blo(o1.y), bhi(o1.y), blo(o1.z), bhi(o1.z), blo(o1.w), bhi(o1.w)};
        float r[16] = {blo(r0.x), bhi(r0.x), blo(r0.y), bhi(r0.y), blo(r0.z), bhi(r0.z), blo(r0.w), bhi(r0.w), blo(r1.x), bhi(r1.x), blo(r1.y), bhi(r1.y), blo(r1.z), bhi(r1.z), blo(r1.w), bhi(r1.w)};
        float q = 0.f;
#pragma unroll
        for (int i = 0; i < 16; ++i) q += o[i] * o[i];
        q += __shfl_xor(q, 1); q += __shfl_xor(q, 2); q += __shfl_xor(q, 4); q += __shfl_xor(q, 8);
        const float rs = rsqrtf(q * (1.0f / 256.0f) + 1e-6f);
        float v[16];
#pragma unroll
        for (int i = 0; i < 16; ++i) v[i] = o[i] * rs * gn[i] * silu(r[i]);
        u32x4 w0, w1;
        w0.x = pk2(v[0], v[1]); w0.y = pk2(v[2], v[3]); w0.z = pk2(v[4], v[5]); w0.w = pk2(v[6], v[7]);
        w1.x = pk2(v[8], v[9]); w1.y = pk2(v[10], v[11]); w1.z = pk2(v[12], v[13]); w1.w = pk2(v[14], v[15]);
        *((u32x4*)(A2 + (size_t)m * DM) + 2 * lane) = w0; *((u32x4*)(A2 + (size_t)m * DM) + 2 * lane + 1) = w1;
    }
}
__device__ __forceinline__ void final_norm(ArgP a, int gw, int NGW, int lane) {
    const bf16_t* __restrict__ XL = (const bf16_t*)(a->ws + OFF_X); const bf16_t* __restrict__ XH = (const bf16_t*)(a->ws + OFF_XB); const float* __restrict__ gfin = a->in[I_NFIN];
#pragma unroll 4
    for (int m = gw; m < MR; m += NGW) {
        float* __restrict__ dst;
        if (m < MP) { const int b = m / LP, t = m - b * LP; if (t < NMETA) continue; dst = a->out + OUT_YP + ((size_t)b * 2048 + (t - NMETA)) * DM; }
        else dst = a->out + OUT_YS + (size_t)(m - MP) * DM;
        f32x4 v[4]; float s = 0.f;
#pragma unroll
        for (int j = 0; j < 4; ++j) { const u32x2 hh = *((const u32x2*)(XH + (size_t)m * DM) + 64 * j + lane), ll = RESID_LO ? *((const u32x2*)(XL + (size_t)m * DM) + 64 * j + lane) : (u32x2){0u, 0u};
            v[j] = (f32x4){blo(hh.x) + blo(ll.x), bhi(hh.x) + bhi(ll.x), blo(hh.y) + blo(ll.y), bhi(hh.y) + bhi(ll.y)}; s += (v[j][0] * v[j][0] + v[j][1] * v[j][1]) + (v[j][2] * v[j][2] + v[j][3] * v[j][3]); }
        const float rs = rsqrtf(wave_sum(s) * (1.0f / 1024.0f) + 1e-6f);
#pragma unroll
        for (int j = 0; j < 4; ++j) { const f32x4 gg = *((const f32x4*)gfin + 64 * j + lane); __builtin_nontemporal_store(v[j] * rs * gg, (f32x4*)dst + 64 * j + lane); }
    }
}

constexpr int PM_SPLIT = 64, ROW_SPLIT = PM_SPLIT * 256;
template <int K>
__device__ __forceinline__ void resid_gemm(const bf16_t* A, const bf16_t* Wt, unsigned char* ws, PG8_LAS unsigned char* ring, int wg, int G, int gw, int NGW, int lane, const XcdBarrier& bar) {
    bf16_t* X = (bf16_t*)(ws + OFF_X); bf16_t* XB = (bf16_t*)(ws + OFF_XB); float* SS = (float*)(ws + OFF_SS);
    {
        pg8::Gemm g{A, Wt, ROW_SPLIT, DM, K, K}; pg8::StaticOrder S; S.init(ROW_SPLIT, DM, G, wg);
        pg8::EpiResid E{X, XB, SS};
        pg8::gemm_phase<pg8::EpiResid, pg8::StaticOrder, true, true>(ring, g, S, E);
#if PROBE_MASK & 4096
        { pg8::EpiProj E2{(bf16_t*)(ws + OFF_O), SS, DM}; pg8::gemm_phase<pg8::EpiProj, pg8::StaticOrder, true, true>(ring, g, S, E2); }
#endif
#if PROBE_MASK & 16384
        { pg8::EpiResidT<true> E2{X, XB, SS}; pg8::gemm_phase<pg8::EpiResidT<true>, pg8::StaticOrder, true, true>(ring, g, S, E2); }
#endif
    }
    {
        int kslice = 256; asm volatile("" : "+s"(kslice));
        pg8::Gemm g{A, Wt, MPAD, DM, kslice, K}; pg8::SplitOrder S{PM_SPLIT, MPAD / 256 - PM_SPLIT, DM / 256, K / 256, 512, G, wg};
        pg8::EpiPart E{(bf16_t*)(ws + OFF_PART), ROW_SPLIT, MPAD - ROW_SPLIT};
        pg8::gemm_phase<pg8::EpiPart, pg8::SplitOrder, true, true>(ring, g, S, E);
#if PROBE_MASK & 8192
        pg8::gemm_phase<pg8::EpiPart, pg8::SplitOrder, true, true>(ring, g, S, E);
#endif
    }
    xcd_barrier(bar);
    constexpr int nks = K / 256;
    const bf16_t* PART = (const bf16_t*)(ws + OFF_PART);
    const int wave_ = gw % NWAVES, wg_ = gw / NWAVES;
    for (int m = ROW_SPLIT + wave_ * G + wg_; m < MPAD; m += NGW) {
        float s = 0.f;
#pragma unroll
        for (int j = 0; j < 4; ++j) {
            const u32x2 hh = *((const u32x2*)(XB + (size_t)m * DM) + 64 * j + lane), ll = RESID_LO ? *((const u32x2*)(X + (size_t)m * DM) + 64 * j + lane) : (u32x2){0u, 0u};
            f32x4 v = {blo(hh.x) + blo(ll.x), bhi(hh.x) + bhi(ll.x), blo(hh.y) + blo(ll.y), bhi(hh.y) + bhi(ll.y)};
            u32x2 p[nks];
#pragma unroll
            for (int ks = 0; ks < nks; ++ks) p[ks] = *((const u32x2*)(PART + ((size_t)ks * (MPAD - ROW_SPLIT) + (m - ROW_SPLIT)) * DM) + 64 * j + lane);
#pragma unroll
            for (int ks = 0; ks < nks; ++ks) v = v + (f32x4){blo(p[ks].x), bhi(p[ks].x), blo(p[ks].y), bhi(p[ks].y)};
            u32x2 w; w.x = pk2(v[0], v[1]); w.y = pk2(v[2], v[3]);
            u32x2 wl; wl.x = pk2(v[0] - blo(w.x), v[1] - bhi(w.x)); wl.y = pk2(v[2] - blo(w.y), v[3] - bhi(w.y));
            *((u32x2*)(XB + (size_t)m * DM) + 64 * j + lane) = w;
            if (RESID_LO) *((u32x2*)(X + (size_t)m * DM) + 64 * j + lane) = wl;
            s += (v[0] * v[0] + v[1] * v[1]) + (v[2] * v[2] + v[3] * v[3]);
        }
        s = wave_sum(s);
        if (lane < 16) SS[(size_t)m * 16 + lane] = (lane == 0) ? s : 0.f;
    }
}

__global__ void __launch_bounds__(NTHR, 2) trunk_fwd(Args args) {
    extern __shared__ __attribute__((aligned(16))) unsigned char lds[];
    const int ph_lo = args.ph_lo, ph_hi = args.ph_hi;
    XcdBarrier bar; bar.bar = nullptr; bar.x = 0; bar.st = nullptr;
    if (ph_hi - ph_lo > 1) {
        volatile LAS unsigned* st = (volatile LAS unsigned*)((LAS unsigned char*)lds + LDS_BYTES - 64);
        if (threadIdx.x < 2) st[threadIdx.x] = 0u;
        __syncthreads();
        bar = xcd_barrier_post((unsigned*)(args.ws + 4096), st);
    }
    for (int ph = ph_lo; ph < ph_hi; ++ph) {
#if PROBE_MASK
      for (int rep = 0; rep < 2; ++rep) {
        if (rep == 1) {
            bool again = false;
            if (ph == 0) again = (PROBE_MASK & 1) != 0; else if (ph == NPHASE - 1) again = (PROBE_MASK & 256) != 0;
            else { const int l_ = (ph - 1) / 10, st_ = (ph - 1) % 10; const bool ev_ = (l_ & 1) == 0;
                if (st_ == 3) again = ev_ ? (PROBE_MASK & 2) != 0 : (PROBE_MASK & 8) != 0;
                else if (st_ == 4) again = ev_ ? (PROBE_MASK & 1024) != 0 : (PROBE_MASK & 2048) != 0;
                else if (st_ == 5) again = ev_ ? (PROBE_MASK & 4) != 0 : (PROBE_MASK & 16) != 0;
                else if (st_ == 0 || st_ == 8) again = (PROBE_MASK & 32) != 0;
                else if (st_ == 2) again = (PROBE_MASK & 64) != 0;
                else if (st_ == 6) again = ev_ && (PROBE_MASK & 128) != 0; }
            if (!again) break;
        }
#endif
        const ArgP ap = arg_ptr();
        const int tid = ltid(), lane = tid & 63, wave = __builtin_amdgcn_readfirstlane(tid >> 6);
        const int wg = lwg(), G = lgrid();
        const int gw = wg * NWAVES + wave, NGW = G * NWAVES;
        unsigned char* ws = ap->ws;
        PG8_LAS unsigned char* ring = (PG8_LAS unsigned char*)lds;
        if (ph == 0) {
            phase_prologue(ap, lds, wg, G);
        } else if (ph == NPHASE - 1) {
            final_norm(ap, gw, NGW, lane);
        } else {
            const int l = (ph - 1) / 10, st = (ph - 1) % 10, li = l >> 1; const bool even = (l & 1) == 0;
            if (st == 0 || st == 8) {
                pg8::Gemm g{(const bf16_t*)(ws + OFF_XB), w_gu(ws, l, st == 8), MPAD, NGU, DM, DM}; pg8::StaticOrder S; S.init(MPAD, NGU, G, wg);
                pg8::EpiGU E{(bf16_t*)(ws + OFF_HP), (const float*)(ws + OFF_SS), DFF};
                pg8::gemm_phase<pg8::EpiGU, pg8::StaticOrder, true, true>(ring, g, S, E);
            } else if (st == 1 || st == 9) {
                resid_gemm<DFF>((const bf16_t*)(ws + OFF_HP), w_dn(ws, l, st == 9), ws, ring, wg, G, gw, NGW, lane, bar);
            } else if (st == 2) {
                const int N = even ? NAB : NGLAP;
                pg8::Gemm g{(const bf16_t*)(ws + OFF_XB), even ? w_abin(ws, li) : w_gin(ws, li), MPAD, N, DM, DM}; pg8::StaticOrder S; S.init(MPAD, N, G, wg);
                pg8::EpiProj E{(bf16_t*)(ws + OFF_HP), (const float*)(ws + OFF_SS), N};
                pg8::gemm_phase<pg8::EpiProj, pg8::StaticOrder, true, true>(ring, g, S, E);
            } else if (st == 3) {
                if (even) { la_prep<64, false>(ap, li, lds, wg, G); __syncthreads(); s5_pass1(ap, li, lds, gw, NGW, lane, wave); }
                else la_prep<128, true>(ap, li, lds, wg, G);
            } else if (st == 4) {
                if (even) { la_prompt<64, 128, 16, false>(ap, li, lds, wg, G); la_sample<64, 128, false>(ap, li, lds, wg, G); __syncthreads(); s5_pass2(ap, li, lds, gw, NGW, lane, wave); }
                else { la_prompt<128, 256, 32, true>(ap, li, lds, wg, G); la_sample<128, 256, true>(ap, li, lds, wg, G); }
            } else if (st == 5) {
                if (even) {
                    pg8::Gemm g{(const bf16_t*)(ws + OFF_Z), w_glu(ws, li), MPAD, 512, 512, 512}; pg8::StaticOrder S; S.init(MPAD, 512, G, wg);
                    pg8::EpiGlu E{(const bf16_t*)(ws + OFF_Z), (bf16_t*)(ws + OFF_A2)};
                    pg8::gemm_phase<pg8::EpiGlu, pg8::StaticOrder, true, true>(ring, g, S, E);
                    ret_finalize(ap, gw, NGW, lane);
                }
                else gla_finalize(ap, li, gw, NGW, lane);
            } else if (st == 6) {
            } else {
                resid_gemm<DM>((const bf16_t*)(ws + OFF_A2), even ? w_about(ws, li) : w_gout(ws, li), ws, ring, wg, G, gw, NGW, lane, bar);
            }
        }
#if PROBE_MASK
      }
#endif
        const bool empty_slot = (ph >= 1 && ph < NPHASE - 1 && ((ph - 1) % 10) == 6);
        if (ph + 1 < ph_hi && !empty_slot) {
            if (ph_hi < 0) { __threadfence(); cg::this_grid().sync(); }
            { xcd_barrier(bar); if (PROBE_MASK & 512) { xcd_barrier(bar); xcd_barrier(bar); } }
        }
    }
}

#ifndef N_LAUNCH_MODE
#define N_LAUNCH_MODE 1
#endif
extern "C" void kernel_launch(void* const* d_in, const int* in_sizes, int n_in, void* d_out, int out_size, void* d_ws, size_t ws_size, hipStream_t stream) {
    static int grid = 0;
    if (grid == 0) {
        if (n_in != N_IN || (size_t)out_size != OUT_END || ws_size < WS_END) { fprintf(stderr, "kernel_launch: unexpected sizes n_in %d out %d ws %zu (need %zu)\n", n_in, out_size, ws_size, (size_t)WS_END); grid = -1; return; }
        int dev = 0, cus = 0, per_cu = 0;
        (void)hipGetDevice(&dev); (void)hipDeviceGetAttribute(&cus, hipDeviceAttributeMultiprocessorCount, dev);
        if (hipFuncSetAttribute((const void*)trunk_fwd, hipFuncAttributeMaxDynamicSharedMemorySize, LDS_BYTES) != hipSuccess) { fprintf(stderr, "kernel_launch: hipFuncSetAttribute failed\n"); grid = -1; return; }
        if (hipOccupancyMaxActiveBlocksPerMultiprocessor(&per_cu, (const void*)trunk_fwd, NTHR, LDS_BYTES) != hipSuccess || per_cu < 1) { fprintf(stderr, "kernel_launch: occupancy query says %d\n", per_cu); per_cu = 1; }
        (void)hipGetLastError();
        grid = cus * 1;
        if (grid <= 0) grid = 256;
    }
    if (grid < 0) return;
    Args a{};
    for (int i = 0; i < N_IN; ++i) a.in[i] = (const float*)d_in[i];
    a.out = (float*)d_out; a.ws = (unsigned char*)d_ws;
#if N_LAUNCH_MODE == 1
    if (hipMemsetAsync(d_ws, 0, 65536, stream) != hipSuccess) { fprintf(stderr, "kernel_launch: memset failed\n"); return; }
    a.ph_lo = 0; a.ph_hi = NPHASE;
    void* kargs[] = {&a};
    hipError_t e = hipLaunchCooperativeKernel((const void*)trunk_fwd, dim3(grid), dim3(NTHR), kargs, LDS_BYTES, stream);
    if (e != hipSuccess) fprintf(stderr, "kernel_launch: cooperative launch failed: %s (grid %d)\n", hipGetErrorString(e), grid);
#else
    for (int ph = 0; ph < NPHASE; ++ph) {
        if (ph >= 1 && ph < NPHASE - 1 && ((ph - 1) % 10) == 6 && (((ph - 1) / 10) & 1)) continue;
        a.ph_lo = ph; a.ph_hi = ph + 1;
        hipLaunchKernelGGL(trunk_fwd, dim3(grid), dim3(NTHR), LDS_BYTES, stream, a);
    }
#endif
}
```

```cpp
#include <hip/hip_runtime.h>
#include <hip/hip_cooperative_groups.h>
#include <cstdio>
#include <cstdint>
namespace cg = cooperative_groups;
#define RESID_LO 0
#define PROBE_MASK 0
__device__ __forceinline__ int ltid() { int t = threadIdx.x; asm volatile("" : "+v"(t)); return t; }
__device__ __forceinline__ int lwg() { int t = blockIdx.x; asm volatile("" : "+s"(t)); return t; }
__device__ __forceinline__ int lgrid() { int t = gridDim.x; asm volatile("" : "+s"(t)); return t; }
namespace pg8 {
#define PG8_LAS __attribute__((address_space(3)))
typedef unsigned short bf16_t;
typedef short bf16x8 __attribute__((ext_vector_type(8)));
typedef float f32x4 __attribute__((ext_vector_type(4)));
typedef unsigned u32x4 __attribute__((ext_vector_type(4)));
constexpr int BM = 256, BK = 64, HALF = 128, HTB = HALF * BK * 2  , STAGE_BYTES = 8 * HTB, NXCD = 8, WGM = 8;

__host__ __device__ __forceinline__ int lds_byte(int r, int c) { const int st = (r >> 4) * 2 + (c >> 5), rr = r & 15, cc = c & 31, ob = rr * 64 + cc * 2; return st * 1024 + (ob ^ (((ob >> 9) & 1) << 5)); }
__host__ __device__ __forceinline__ void stage_rc(int b, int& R, int& C) { const int st = b / 1024, sb = b % 1024, swz = sb ^ (((sb >> 9) & 1) << 5); R = (st >> 1) * 16 + swz / 64; C = (st & 1) * 32 + (swz % 64) / 2; }
__host__ __device__ __forceinline__ int perm32(int rho) { const int n = rho >> 4, i = rho & 15; return 8 * (i >> 2) + 4 * n + (i & 3); }

struct Unit { int pm, pn, kofs; };
struct Gemm { const bf16_t* A; const bf16_t* Bt; int M, N, K, ld; };

struct StaticOrder {
    static constexpr bool SPLIT = false;
    int nM, nN, nwg, G, c;
    __host__ __device__ void init(int M, int N, int G_, int c_) { nM = M / BM; nN = N / BM; nwg = nM * nN; G = G_; c = c_; }
    __host__ __device__ bool next(int i, Unit& u) const {
        const long L = (long)i * G + c; if (L >= nwg) return false;
        int wgid = (int)L; { const int q = nwg / NXCD, r = nwg % NXCD, xcd = wgid % NXCD, off = wgid / NXCD; wgid = (xcd < r ? xcd * (q + 1) : r * (q + 1) + (xcd - r) * q) + off; }
        const int nig = WGM * nN, gid = wgid / nig, fm = gid * WGM, gsz = (nM - fm) < WGM ? (nM - fm) : WGM;
        u.pm = fm + ((wgid % nig) % gsz); u.pn = (wgid % nig) / gsz; u.kofs = 0; return true;
    }
    __device__ __forceinline__ void a_ready(const Unit&) const {}
    __device__ __forceinline__ void done(const Unit&) const {}
};

struct SplitOrder {
    static constexpr bool SPLIT = true;
    int pm0, npm, nN, nks, kslice_bytes, G, c;
    __host__ __device__ bool next(int i, Unit& u) const {
        const long L = (long)i * G + c; if (L >= (long)npm * nN * nks) return false;
        const int l = (int)L; u.kofs = (l % nks) * kslice_bytes; u.pn = (l / nks) % nN; u.pm = pm0 + l / (nks * nN); return true;
    }
    __device__ __forceinline__ void a_ready(const Unit&) const {}
    __device__ __forceinline__ void done(const Unit&) const {}
};
__device__ __forceinline__ unsigned cvt_pk_bf16(float lo, float hi) { unsigned r; asm volatile("v_cvt_pk_bf16_f32 %0, %1, %2" : "=v"(r) : "v"(lo), "v"(hi)); return r; }
typedef float f32x2 __attribute__((ext_vector_type(2)));
typedef unsigned u32x2 __attribute__((ext_vector_type(2)));
__device__ __forceinline__ float row_rs(const float* SS, int row) {
    const f32x4* p = (const f32x4*)(SS + (size_t)row * 16);
    const f32x4 a = p[0], b = p[1], c = p[2], d = p[3];
    const float s = (((a[0] + a[1]) + (a[2] + a[3])) + ((b[0] + b[1]) + (b[2] + b[3]))) + (((c[0] + c[1]) + (c[2] + c[3])) + ((d[0] + d[1]) + (d[2] + d[3])));
    return __builtin_amdgcn_rsqf(s * (1.0f / 1024.0f) + 1e-6f);
}
__device__ __forceinline__ void row_rs8(const float* SS, int row0, int fq, float (&rr)[8]) {
    f32x4 pp[8];
#pragma unroll
    for (int g = 0; g < 8; ++g) pp[g] = *(const f32x4*)(SS + (size_t)(row0 + (g >> 2) * HALF + (g & 3) * 16) * 16 + 4 * fq);
#pragma unroll
    for (int g = 0; g < 8; ++g) {
        float s = (pp[g][0] + pp[g][1]) + (pp[g][2] + pp[g][3]);
        s += __shfl_xor(s, 16); s += __shfl_xor(s, 32);
        rr[g] = __builtin_amdgcn_rsqf(s * (1.0f / 1024.0f) + 1e-6f);
    }
}
__device__ __forceinline__ float silu_f(float x) { return x * __builtin_amdgcn_rcpf(1.0f + __expf(-x)); }
__device__ __forceinline__ float sigm_f(float x) { return __builtin_amdgcn_rcpf(1.0f + __expf(-x)); }
__device__ __forceinline__ float bfu_lo(unsigned w) { return __uint_as_float(w << 16); }
__device__ __forceinline__ float bfu_hi(unsigned w) { return __uint_as_float(w & 0xffff0000u); }

struct EpiGU {
    static constexpr bool PERM = true, AFTER_DRAIN = false;
    bf16_t* H; const float* SS; int ldh;
    __device__ __forceinline__ void operator()(const f32x4 (&acc)[2][2][4][2], const Unit& u, int wr, int wc, int fr, int fq) const {
        const int row0 = u.pm * BM + wr * 64 + fr, col0 = u.pn * 128 + wc * 32 + 8 * fq;
        float rr[8]; row_rs8(SS, row0, fq, rr);
#pragma unroll
        for (int ai = 0; ai < 2; ++ai)
#pragma unroll
            for (int m = 0; m < 4; ++m) {
                const int row = row0 + ai * HALF + m * 16; const float r = rr[ai * 4 + m];
                const f32x4 g0 = acc[ai][0][m][0] * r, g1 = acc[ai][0][m][1] * r, u0 = acc[ai][1][m][0] * r, u1 = acc[ai][1][m][1] * r;
                u32x4 w;
                w.x = cvt_pk_bf16(silu_f(g0[0]) * u0[0], silu_f(g0[1]) * u0[1]); w.y = cvt_pk_bf16(silu_f(g0[2]) * u0[2], silu_f(g0[3]) * u0[3]);
                w.z = cvt_pk_bf16(silu_f(g1[0]) * u1[0], silu_f(g1[1]) * u1[1]); w.w = cvt_pk_bf16(silu_f(g1[2]) * u1[2], silu_f(g1[3]) * u1[3]);
                *(u32x4*)(H + (size_t)row * ldh + col0) = w;
            }
    }
};
struct EpiProj {
    static constexpr bool PERM = true, AFTER_DRAIN = false;
    bf16_t* O; const float* SS; int ldc;
    __device__ __forceinline__ void operator()(const f32x4 (&acc)[2][2][4][2], const Unit& u, int wr, int wc, int fr, int fq) const {
        const int row0 = u.pm * BM + wr * 64 + fr, col0 = u.pn * BM + wc * 32 + 8 * fq;
        float rr[8]; row_rs8(SS, row0, fq, rr);
#pragma unroll
        for (int ai = 0; ai < 2; ++ai)
#pragma unroll
            for (int m = 0; m < 4; ++m) {
                const int row = row0 + ai * HALF + m * 16; const float r = rr[ai * 4 + m];
#pragma unroll
                for (int bj = 0; bj < 2; ++bj) {
                    const f32x4 v0 = acc[ai][bj][m][0] * r, v1 = acc[ai][bj][m][1] * r;
                    u32x4 w; w.x = cvt_pk_bf16(v0[0], v0[1]); w.y = cvt_pk_bf16(v0[2], v0[3]); w.z = cvt_pk_bf16(v1[0], v1[1]); w.w = cvt_pk_bf16(v1[2], v1[3]);
                    *(u32x4*)(O + (size_t)row * ldc + col0 + bj * HALF) = w;
                }
            }
    }
};
template <bool ZERO = false> struct EpiResidT {
    static constexpr bool PERM = true, AFTER_DRAIN = false;
    bf16_t* XL; bf16_t* XB; float* SS;
    __device__ __forceinline__ void operator()(const f32x4 (&acc)[2][2][4][2], const Unit& u, int wr, int wc, int fr, int fq) const {
        const int row0 = u.pm * BM + wr * 64 + fr, col0 = u.pn * BM + wc * 32 + 8 * fq;
        u32x4 xin[2][4];
#pragma unroll
        for (int bj = 0; bj < 2; ++bj) { const size_t o = (size_t)row0 * 1024 + col0 + bj * HALF; xin[0][2 * bj] = *(const u32x4*)(XB + o); xin[0][2 * bj + 1] = RESID_LO ? *(const u32x4*)(XL + o) : (u32x4){0u, 0u, 0u, 0u}; }
#pragma unroll
        for (int gI = 0; gI < 8; ++gI) {
            const int ai = gI >> 2, m = gI & 3, cur = gI & 1, nxt = cur ^ 1;
            const int row = row0 + ai * HALF + m * 16;
            if (gI + 1 < 8) {
                const int rown = row0 + ((gI + 1) >> 2) * HALF + ((gI + 1) & 3) * 16;
#pragma unroll
                for (int bj = 0; bj < 2; ++bj) { const size_t o = (size_t)rown * 1024 + col0 + bj * HALF; xin[nxt][2 * bj] = *(const u32x4*)(XB + o); xin[nxt][2 * bj + 1] = RESID_LO ? *(const u32x4*)(XL + o) : (u32x4){0u, 0u, 0u, 0u}; }
            }
            float ss = 0.f;
#pragma unroll
            for (int bj = 0; bj < 2; ++bj) {
                const size_t o = (size_t)row * 1024 + col0 + bj * HALF;
                const u32x4 h = xin[cur][2 * bj], l = xin[cur][2 * bj + 1];
                f32x4 x0 = {bfu_lo(h.x) + bfu_lo(l.x), bfu_hi(h.x) + bfu_hi(l.x), bfu_lo(h.y) + bfu_lo(l.y), bfu_hi(h.y) + bfu_hi(l.y)};
                f32x4 x1 = {bfu_lo(h.z) + bfu_lo(l.z), bfu_hi(h.z) + bfu_hi(l.z), bfu_lo(h.w) + bfu_lo(l.w), bfu_hi(h.w) + bfu_hi(l.w)};
                if (!ZERO) { x0 = x0 + acc[ai][bj][m][0]; x1 = x1 + acc[ai][bj][m][1]; } else { x0 = x0 + acc[ai][bj][m][0] * 0.f; x1 = x1 + acc[ai][bj][m][1] * 0.f; }
                ss += ((x0[0] * x0[0] + x0[1] * x0[1]) + (x0[2] * x0[2] + x0[3] * x0[3])) + ((x1[0] * x1[0] + x1[1] * x1[1]) + (x1[2] * x1[2] + x1[3] * x1[3]));
                u32x4 wh; wh.x = cvt_pk_bf16(x0[0], x0[1]); wh.y = cvt_pk_bf16(x0[2], x0[3]); wh.z = cvt_pk_bf16(x1[0], x1[1]); wh.w = cvt_pk_bf16(x1[2], x1[3]);
                u32x4 wl;
                wl.x = cvt_pk_bf16(x0[0] - bfu_lo(wh.x), x0[1] - bfu_hi(wh.x)); wl.y = cvt_pk_bf16(x0[2] - bfu_lo(wh.y), x0[3] - bfu_hi(wh.y));
                wl.z = cvt_pk_bf16(x1[0] - bfu_lo(wh.z), x1[1] - bfu_hi(wh.z)); wl.w = cvt_pk_bf16(x1[2] - bfu_lo(wh.w), x1[3] - bfu_hi(wh.w));
                *(u32x4*)(XB + o) = wh; if (RESID_LO) *(u32x4*)(XL + o) = wl;
            }
            ss += __shfl_xor(ss, 16); ss += __shfl_xor(ss, 32);
            if (fq == 0) SS[(size_t)row * 16 + u.pn * 4 + wc] = ss;
        }
    }
};
typedef EpiResidT<false> EpiResid;
struct EpiGlu {
    static constexpr bool PERM = true, AFTER_DRAIN = false;
    const bf16_t* Z; bf16_t* A2;
    __device__ __forceinline__ void operator()(const f32x4 (&acc)[2][2][4][2], const Unit& u, int wr, int wc, int fr, int fq) const {
        const int row0 = u.pm * BM + wr * 64 + fr, col0 = u.pn * BM + wc * 32 + 8 * fq;
#pragma unroll
        for (int ai = 0; ai < 2; ++ai) {
            u32x4 zz[4][2];
#pragma unroll
            for (int m = 0; m < 4; ++m)
#pragma unroll
                for (int bj = 0; bj < 2; ++bj) zz[m][bj] = *(const u32x4*)(Z + (size_t)(row0 + ai * HALF + m * 16) * 512 + col0 + bj * HALF);
#pragma unroll
            for (int m = 0; m < 4; ++m) {
                const int row = row0 + ai * HALF + m * 16;
#pragma unroll
                for (int bj = 0; bj < 2; ++bj) {
                    const u32x4 z = zz[m][bj];
                    const f32x4 v0 = acc[ai][bj][m][0], v1 = acc[ai][bj][m][1];
                    u32x4 w;
                    w.x = cvt_pk_bf16(bfu_lo(z.x) * sigm_f(v0[0]), bfu_hi(z.x) * sigm_f(v0[1])); w.y = cvt_pk_bf16(bfu_lo(z.y) * sigm_f(v0[2]), bfu_hi(z.y) * sigm_f(v0[3]));
                    w.z = cvt_pk_bf16(bfu_lo(z.z) * sigm_f(v1[0]), bfu_hi(z.z) * sigm_f(v1[1])); w.w = cvt_pk_bf16(bfu_lo(z.w) * sigm_f(v1[2]), bfu_hi(z.w) * sigm_f(v1[3]));
                    *(u32x4*)(A2 + (size_t)row * 1024 + col0 + bj * HALF) = w;
                }
            }
        }
    }
};
struct EpiPart {
    static constexpr bool PERM = true, AFTER_DRAIN = false;
    bf16_t* P; int row_base, nrows;
    __device__ __forceinline__ void operator()(const f32x4 (&acc)[2][2][4][2], const Unit& u, int wr, int wc, int fr, int fq) const {
        const int row0 = u.pm * BM + wr * 64 + fr - row_base, col0 = u.pn * BM + wc * 32 + 8 * fq;
        bf16_t* base = P + (size_t)(u.kofs >> 9) * nrows * 1024;
#pragma unroll
        for (int ai = 0; ai < 2; ++ai)
#pragma unroll
            for (int m = 0; m < 4; ++m) {
                const int row = row0 + ai * HALF + m * 16;
#pragma unroll
                for (int bj = 0; bj < 2; ++bj) {
                    const f32x4 v0 = acc[ai][bj][m][0], v1 = acc[ai][bj][m][1];
                    u32x4 w; w.x = cvt_pk_bf16(v0[0], v0[1]); w.y = cvt_pk_bf16(v0[2], v0[3]); w.z = cvt_pk_bf16(v1[0], v1[1]); w.w = cvt_pk_bf16(v1[2], v1[3]);
                    *(u32x4*)(base + (size_t)row * 1024 + col0 + bj * HALF) = w;
                }
            }
    }
};
template <class Epi, class Sched, bool ALIGN_EPI = false, bool SP2 = false>
__device__ __forceinline__ void gemm_phase(PG8_LAS unsigned char* lds, const Gemm g, const Sched& S, const Epi& E) {
    const int tid = ltid(), wid = __builtin_amdgcn_readfirstlane(tid >> 6), lane = tid & 63, wr = wid >> 2, wc = wid & 3, fr = lane & 15, fq = lane >> 4;
    const int K = g.ld, nt = g.K / BK;
    unsigned voffA[2], voffB[2];
#pragma unroll
    for (int i = 0; i < 2; ++i) { int R, C; stage_rc(tid * 16 + i * 8192, R, C); const int Rb = Epi::PERM ? ((R & ~31) + perm32(R & 31)) : R;
        voffA[i] = (unsigned)(R * K + C) * 2u; voffB[i] = (unsigned)(Rb * K + C) * 2u; }
    const size_t kstep = (size_t)(BK * 2);
    const size_t hstep = (size_t)HALF * K * 2;
    const size_t tstep = 2 * hstep;
    const unsigned ldsw = (unsigned)wid * 1024u;
    const int aoff = lds_byte(wr * 64 + fr, fq * 8), boff = lds_byte(wc * 32 + fr, fq * 8);
#define PG8_SA(b, h) (((b) * 2 + (h)) * HTB)
#define PG8_SB(b, h) ((4 + (b) * 2 + (h)) * HTB)
#define PG8_STAGE(bufoff, gbase, voff) do { _Pragma("unroll") for (int _i = 0; _i < 2; ++_i) \
        __builtin_amdgcn_global_load_lds((const unsigned*)((const char*)(gbase) + (voff)[_i]), (PG8_LAS unsigned*)(lds + (bufoff) + ldsw + _i * 8192), 16, 0, 0); } while (0)
#define PG8_LDA(dst, b, h) do { _Pragma("unroll") for (int m = 0; m < 4; ++m) _Pragma("unroll") for (int k = 0; k < 2; ++k) dst[m][k] = *(const PG8_LAS bf16x8*)(lds + PG8_SA(b, h) + aoff + m * 2048 + k * 1024); } while (0)
#define PG8_LDB(dst, b, h) do { _Pragma("unroll") for (int n = 0; n < 2; ++n) _Pragma("unroll") for (int k = 0; k < 2; ++k) dst[n][k] = *(const PG8_LAS bf16x8*)(lds + PG8_SB(b, h) + boff + n * 2048 + k * 1024); } while (0)
#define PG8_MMA(ai, bj, At, Bt) do { __builtin_amdgcn_s_setprio(1); _Pragma("unroll") for (int m = 0; m < 4; ++m) _Pragma("unroll") for (int n = 0; n < 2; ++n) _Pragma("unroll") for (int k = 0; k < 2; ++k) \
        acc[ai][bj][m][n] = __builtin_amdgcn_mfma_f32_16x16x32_bf16(Bt[n][k], At[m][k], acc[ai][bj][m][n], 0, 0, 0); __builtin_amdgcn_s_setprio(0); } while (0)
#define PG8_WAIT_V(n) asm volatile("s_waitcnt vmcnt(" #n ")" ::: "memory")
#define PG8_WAIT_L(n) asm volatile("s_waitcnt lgkmcnt(" #n ")" ::: "memory")
#define PG8_BAR __builtin_amdgcn_s_barrier()
#define PG8_SCHED __builtin_amdgcn_sched_barrier(0)
    Unit cur, nxt; int ui = 0;
    if (!S.next(0, cur)) return;
    f32x4 acc[2][2][4][2];
#pragma unroll
    for (int a = 0; a < 2; ++a)
#pragma unroll
        for (int b = 0; b < 2; ++b)
#pragma unroll
            for (int m = 0; m < 4; ++m)
#pragma unroll
                for (int n = 0; n < 2; ++n) acc[a][b][m][n] = (f32x4){0.f, 0.f, 0.f, 0.f};
    bf16x8 At[4][2], B0[2][2], B1[2][2];
    const char* cA = (const char*)g.A + (size_t)cur.pm * tstep + (Sched::SPLIT ? cur.kofs : 0); const char* cB = (const char*)g.Bt + (size_t)cur.pn * tstep + (Sched::SPLIT ? cur.kofs : 0);
    S.a_ready(cur);
    if constexpr (SP2) {
        PG8_STAGE(PG8_SB(0, 0), cB, voffB); PG8_STAGE(PG8_SB(0, 1), cB + hstep, voffB); PG8_STAGE(PG8_SA(0, 0), cA, voffA); PG8_STAGE(PG8_SA(0, 1), cA + hstep, voffA);
        if (wr == 1) PG8_BAR;
        PG8_WAIT_V(2); PG8_BAR;
        PG8_STAGE(PG8_SB(1, 0), cB + kstep, voffB); PG8_STAGE(PG8_SA(1, 0), cA + kstep, voffA); PG8_STAGE(PG8_SB(1, 1), cB + hstep + kstep, voffB);
        PG8_WAIT_V(6); PG8_BAR;
    } else {
        PG8_STAGE(PG8_SB(0, 0), cB, voffB); PG8_STAGE(PG8_SA(0, 0), cA, voffA); PG8_STAGE(PG8_SB(0, 1), cB + hstep, voffB); PG8_STAGE(PG8_SA(0, 1), cA + hstep, voffA);
        if (wr == 1) PG8_BAR;
        PG8_WAIT_V(4); PG8_BAR;
        PG8_STAGE(PG8_SB(1, 0), cB + kstep, voffB); PG8_STAGE(PG8_SA(1, 0), cA + kstep, voffA); PG8_STAGE(PG8_SB(1, 1), cB + hstep + kstep, voffB);
        PG8_WAIT_V(6); PG8_BAR;
    }
    for (;;) {
        const bool has_next = S.next(ui + 1, nxt);
        const char* nA = has_next ? (const char*)g.A + (size_t)nxt.pm * tstep + (Sched::SPLIT ? nxt.kofs : 0) : cA; const char* nB = has_next ? (const char*)g.Bt + (size_t)nxt.pn * tstep + (Sched::SPLIT ? nxt.kofs : 0) : cB;
        for (int t = 0; t < nt; t += 2) {
            const bool last = (t == nt - 2);
            const char* a1 = cA + (size_t)(t + 1) * kstep;
            const char* a2 = last ? nA : cA + (size_t)(t + 2) * kstep; const char* b2 = last ? nB : cB + (size_t)(t + 2) * kstep;
            const char* a3 = a2 + kstep; const char* b3 = b2 + kstep;
            if (last && has_next) S.a_ready(nxt);
            if constexpr (SP2) {
            PG8_LDB(B0, 0, 0); PG8_LDB(B1, 0, 1); PG8_SCHED; PG8_LDA(At, 0, 0); PG8_STAGE(PG8_SA(1, 1), a1 + hstep, voffA);
            PG8_WAIT_V(8); PG8_WAIT_L(0); PG8_BAR; PG8_MMA(0, 0, At, B0); PG8_MMA(0, 1, At, B1); PG8_BAR; PG8_SCHED;
            PG8_LDA(At, 0, 1); PG8_STAGE(PG8_SB(0, 0), b2, voffB); PG8_STAGE(PG8_SB(0, 1), b2 + hstep, voffB); PG8_STAGE(PG8_SA(0, 0), a2, voffA);
            PG8_WAIT_V(8); PG8_WAIT_L(0); PG8_BAR; PG8_MMA(1, 0, At, B0); PG8_MMA(1, 1, At, B1); PG8_BAR; PG8_SCHED;
            PG8_LDB(B0, 1, 0); PG8_LDB(B1, 1, 1); PG8_SCHED; PG8_LDA(At, 1, 0); PG8_STAGE(PG8_SA(0, 1), a2 + hstep, voffA);
            PG8_WAIT_V(8); PG8_WAIT_L(0); PG8_BAR; PG8_MMA(0, 0, At, B0); PG8_MMA(0, 1, At, B1); PG8_BAR; PG8_SCHED;
            PG8_LDA(At, 1, 1); PG8_STAGE(PG8_SB(1, 0), b3, voffB); PG8_STAGE(PG8_SB(1, 1), b3 + hstep, voffB); PG8_STAGE(PG8_SA(1, 0), a3, voffA);
            PG8_WAIT_V(8); PG8_WAIT_L(0); PG8_BAR; PG8_MMA(1, 0, At, B0); PG8_MMA(1, 1, At, B1); PG8_BAR; PG8_SCHED;
            } else {
            PG8_LDB(B0, 0, 0); PG8_SCHED; PG8_LDA(At, 0, 0); PG8_STAGE(PG8_SA(1, 1), a1 + hstep, voffA);
            PG8_WAIT_L(8); PG8_BAR; PG8_WAIT_L(0); PG8_MMA(0, 0, At, B0); PG8_BAR; PG8_SCHED;
            PG8_LDB(B1, 0, 1); PG8_STAGE(PG8_SB(0, 0), b2, voffB);
            PG8_BAR; PG8_WAIT_L(0); PG8_MMA(0, 1, At, B1); PG8_BAR;
            PG8_LDA(At, 0, 1); PG8_STAGE(PG8_SA(0, 0), a2, voffA);
            PG8_BAR; PG8_WAIT_L(0); PG8_MMA(1, 0, At, B0); PG8_BAR; PG8_SCHED;
            PG8_STAGE(PG8_SB(0, 1), b2 + hstep, voffB);
            PG8_WAIT_V(6); PG8_BAR; PG8_MMA(1, 1, At, B1); PG8_BAR;
            PG8_LDB(B0, 1, 0); PG8_SCHED; PG8_LDA(At, 1, 0); PG8_STAGE(PG8_SA(0, 1), a2 + hstep, voffA);
            PG8_WAIT_L(8); PG8_BAR; PG8_WAIT_L(0); PG8_MMA(0, 0, At, B0); PG8_BAR; PG8_SCHED;
            PG8_LDB(B1, 1, 1); PG8_STAGE(PG8_SB(1, 0), b3, voffB);
            PG8_BAR; PG8_WAIT_L(0); PG8_MMA(0, 1, At, B1); PG8_BAR;
            PG8_LDA(At, 1, 1); PG8_STAGE(PG8_SA(1, 0), a3, voffA);
            PG8_BAR; PG8_WAIT_L(0); PG8_MMA(1, 0, At, B0); PG8_BAR; PG8_SCHED;
            PG8_STAGE(PG8_SB(1, 1), b3 + hstep, voffB);
            PG8_WAIT_V(6); PG8_BAR; PG8_MMA(1, 1, At, B1); PG8_BAR;
            }
        }
        if constexpr (ALIGN_EPI) { if (wr == 0) PG8_BAR; }
        if constexpr (!Epi::AFTER_DRAIN) { E(acc, cur, wr, wc, fr, fq); S.done(cur); }
        if (!has_next) break;
#pragma unroll
        for (int a = 0; a < 2; ++a)
#pragma unroll
            for (int b = 0; b < 2; ++b)
#pragma unroll
                for (int m = 0; m < 4; ++m)
#pragma unroll
                    for (int n = 0; n < 2; ++n) acc[a][b][m][n] = (f32x4){0.f, 0.f, 0.f, 0.f};
        cur = nxt; cA = nA; cB = nB; ++ui;
        if constexpr (ALIGN_EPI) { if (wr == 1) PG8_BAR; }
    }
    PG8_WAIT_V(0);
    if constexpr (!ALIGN_EPI) { if (wr == 0) PG8_BAR; }
    PG8_BAR;
    if constexpr (Epi::AFTER_DRAIN) { E.fused(acc, cur, wr, wc, fr, fq, lds, wid, lane); S.done(cur); }
#undef PG8_SA
#undef PG8_SB
#undef PG8_STAGE
#undef PG8_LDA
#undef PG8_LDB
#undef PG8_MMA
#undef PG8_WAIT_V
#undef PG8_WAIT_L
#undef PG8_BAR
#undef PG8_SCHED
}
}
#define LAS __attribute__((address_space(3)))
#define XB_TMO      128
#define XB_XCNT(j)  (256  + 64 * (j))
#define XB_XSUB(j)  (1280 + 64 * (j))
#define XB_XGEN(j)  (2304 + 64 * (j))
#define XB_TOP      3328
#define XB_TOPGEN   3392
#define XCD_BAR_WORDS 3456
#define XB_SPIN_CAP (1u << 18)

__device__ __forceinline__ unsigned xb_ld(unsigned* p)              { return __hip_atomic_load(p, __ATOMIC_RELAXED, __HIP_MEMORY_SCOPE_AGENT); }
__device__ __forceinline__ unsigned xb_add(unsigned* p, unsigned v) { return __hip_atomic_fetch_add(p, v, __ATOMIC_RELAXED, __HIP_MEMORY_SCOPE_AGENT); }
__device__ __forceinline__ unsigned xb_xcc_id() { return (unsigned)__builtin_amdgcn_s_getreg((3 << 11) | 20) & 0xFu; }
#define XB_SPIN(cond, bar) do { unsigned _sp = 0; while (cond) { __builtin_amdgcn_s_sleep(1); \
    if ((++_sp & 255u) == 0u) { if (xb_ld(&(bar)[XB_TMO])) break; if (_sp > XB_SPIN_CAP) { atomicAdd(&(bar)[XB_TMO], 1u); break; } } } } while (0)

struct XcdBarrier {
    unsigned* bar; unsigned x;
    volatile LAS unsigned* st;
};

__device__ __forceinline__ XcdBarrier xcd_barrier_post(unsigned* bar, volatile LAS unsigned* st) {
    XcdBarrier b; b.bar = bar; b.x = xb_xcc_id(); b.st = st;
    if (threadIdx.x == 0) (void)xb_add(&bar[XB_XCNT(b.x)], 1u);
    return b;
}
__device__ __forceinline__ void xcd_barrier_complete(unsigned* bar, unsigned x, unsigned& nloc, unsigned& nx) {
    const unsigned G = gridDim.x * gridDim.y * gridDim.z;
    unsigned sum, cnt, mine, sp = 0u;
    for (;;) {
        sum = 0u; cnt = 0u; mine = 0u;
#pragma unroll
        for (unsigned j = 0; j < 16; ++j) { const unsigned c = xb_ld(&bar[XB_XCNT(j)]); sum += c; cnt += (c > 0u) ? 1u : 0u; mine = (j == x) ? c : mine; }
        if (sum == G) break;
        __builtin_amdgcn_s_sleep(1);
        if ((++sp & 255u) == 0u) { if (xb_ld(&bar[XB_TMO])) break; if (sp > XB_SPIN_CAP) { atomicAdd(&bar[XB_TMO], 1u); break; } }
    }
    nloc = mine > 0u ? mine : 1u; nx = cnt > 0u ? cnt : 1u;
}

__device__ __forceinline__ void xcd_barrier(const XcdBarrier& b) {
    asm volatile("s_waitcnt vmcnt(0)" ::: "memory");
    __syncthreads();
    if (threadIdx.x == 0) {
        unsigned* bar = b.bar;
        __builtin_amdgcn_s_waitcnt(0);
        unsigned nloc = b.st[0], nx = b.st[1];
        if (nloc == 0u) { xcd_barrier_complete(bar, b.x, nloc, nx); b.st[0] = nloc; b.st[1] = nx; }
        const unsigned old = xb_add(&bar[XB_XSUB(b.x)], 1u);
        const unsigned gen = old / nloc;
        if (old + 1u == (gen + 1u) * nloc) {
            __builtin_amdgcn_fence(__ATOMIC_RELEASE, "agent");
            asm volatile("s_waitcnt vmcnt(0)" ::: "memory");
            const unsigned og = xb_add(&bar[XB_TOP], 1u);
            const unsigned tg = og / nx;
            if (og + 1u == (tg + 1u) * nx) xb_add(&bar[XB_TOPGEN], 1u);
            else XB_SPIN(xb_ld(&bar[XB_TOPGEN]) == tg, bar);
            __builtin_amdgcn_fence(__ATOMIC_ACQUIRE, "agent");
            xb_add(&bar[XB_XGEN(b.x)], 1u);
            asm volatile("s_waitcnt vmcnt(0)" ::: "memory");
        } else {
            XB_SPIN(xb_ld(&bar[XB_XGEN(b.x)]) == gen, bar);
            __builtin_amdgcn_fence(__ATOMIC_ACQUIRE, "agent");
            asm volatile("s_waitcnt vmcnt(0)" ::: "memory");
        }
    }
    __syncthreads();
}
typedef unsigned short bf16_t;
typedef float f32x4 __attribute__((ext_vector_type(4)));
typedef short bf16x8 __attribute__((ext_vector_type(8)));
typedef unsigned u32x4 __attribute__((ext_vector_type(4)));
typedef unsigned u32x2 __attribute__((ext_vector_type(2)));
constexpr int DM = 1024, NB = 8, LP = 2064, NSB = 128, NST = 8, NMETA = 16;
constexpr int MP = NB * LP;
constexpr int MR = MP + NSB * NST;
constexpr int MPAD = 17664;
constexpr int DFF = 2816, NGU = 5632, NAB = 2048, NGLA = 3088, NGLAP = 3328;
constexpr int NWAVES = 8, NTHR = 512;
constexpr int LDS_BYTES = 147456, RING_BYTES = 131072;
constexpr int NPHASE = 42;
constexpr size_t SZ_WGU = (size_t)NGU * DM * 2, SZ_WD = (size_t)DM * DFF * 2, SZ_FFN = 2 * (SZ_WGU + SZ_WD);
constexpr size_t SZ_WINAB = (size_t)NAB * DM * 2, SZ_WGLU = 512 * 512 * 2, SZ_WOUT = (size_t)DM * DM * 2, SZ_AB = SZ_WINAB + SZ_WGLU + SZ_WOUT;
constexpr size_t SZ_WING = (size_t)NGLAP * DM * 2, SZ_G = SZ_WING + SZ_WOUT;
constexpr size_t OFF_W = 1u << 20;
constexpr size_t OFF_WAB = OFF_W + 4 * SZ_FFN, OFF_WG = OFF_WAB + 2 * SZ_AB;
constexpr size_t OFF_X = OFF_WG + 2 * SZ_G;
constexpr size_t OFF_XB = OFF_X + (size_t)MPAD * DM * 4;
constexpr size_t OFF_SS = OFF_XB + (size_t)MPAD * DM * 2;
constexpr size_t OFF_HP = OFF_SS + (size_t)MPAD * 16 * 4;
constexpr size_t OFF_A2 = OFF_HP + (size_t)MPAD * NGLAP * 2;
constexpr size_t OFF_Z = OFF_A2 + (size_t)MPAD * DM * 2;
constexpr size_t OFF_O = OFF_Z + (size_t)MPAD * 512 * 2;
constexpr size_t OFF_ROT = OFF_O + (size_t)MPAD * DM * 2;
constexpr int NROT = 2072;
constexpr size_t OFF_S5T = OFF_ROT + (size_t)NROT * 32 * 2 * 4;
constexpr size_t S5T_STRIDE_F = 32 * 64 * 2 + 32 * 64 * 32;
constexpr size_t OFF_S5E = OFF_S5T + 2 * S5T_STRIDE_F * 4;
constexpr size_t OFF_PART = OFF_S5E + (size_t)8 * 32 * 16 * 128 * 4;
constexpr size_t WS_END = OFF_PART + (size_t)11 * 1280 * 1024 * 4;
static_assert(OFF_X % 256 == 0 && OFF_HP % 256 == 0 && OFF_ROT % 256 == 0 && OFF_S5E % 256 == 0, "ws alignment");
constexpr size_t OUT_YP = 0, OUT_YS = OUT_YP + (size_t)NB * 2048 * DM, OUT_PS5R = OUT_YS + (size_t)NSB * NST * DM, OUT_PS5I = OUT_PS5R + 2 * 8 * 32 * 64,
                 OUT_PRET = OUT_PS5I + 2 * 8 * 32 * 64, OUT_PGLA = OUT_PRET + (size_t)2 * 8 * 4 * 64 * 128, OUT_SS5R = OUT_PGLA + (size_t)2 * 8 * 4 * 128 * 256,
                 OUT_SS5I = OUT_SS5R + (size_t)2 * 128 * 32 * 64, OUT_SRET = OUT_SS5I + (size_t)2 * 128 * 32 * 64, OUT_SGLA = OUT_SRET + (size_t)2 * 128 * 4 * 64 * 128,
                 OUT_END = OUT_SGLA + (size_t)2 * 128 * 4 * 128 * 256;
enum { I_XP = 0, I_XS, I_S5R, I_S5I, I_SRET, I_SGLA, I_META, I_NF1, I_NMIX, I_NF2, I_NFIN, I_F1GU, I_F1D, I_F2GU, I_F2D, I_ABIN, I_ABOUT, I_S5AR, I_S5AI, I_S5DT,
       I_S5BR, I_S5BI, I_S5CR, I_S5CI, I_S5D, I_S5GLU, I_GIN, I_GA2, I_GBA, I_GNORM, I_GOUT, N_IN };

struct Args { const float* in[N_IN]; float* out; unsigned char* ws; int ph_lo, ph_hi; };
typedef const __attribute__((address_space(4))) Args* ArgP;
__device__ __forceinline__ ArgP arg_ptr() { ArgP p = (ArgP)__builtin_amdgcn_kernarg_segment_ptr(); asm volatile("" : "+s"(p)); return p; }

__device__ __forceinline__ float bf2f(bf16_t v) { return __uint_as_float((unsigned)v << 16); }
__device__ __forceinline__ bf16_t f2bf(float f) { const unsigned u = __float_as_uint(f); return (bf16_t)((u + 0x7fffu + ((u >> 16) & 1u)) >> 16); }
__device__ __forceinline__ unsigned pk2(float lo, float hi) { return (unsigned)f2bf(lo) | ((unsigned)f2bf(hi) << 16); }
__device__ __forceinline__ float blo(unsigned w) { return __uint_as_float(w << 16); }
__device__ __forceinline__ float bhi(unsigned w) { return __uint_as_float(w & 0xffff0000u); }
__device__ __forceinline__ float wave_sum(float v) {
#pragma unroll
    for (int o = 1; o < 64; o <<= 1) v += __shfl_xor(v, o);
    return v;
}
__device__ __forceinline__ float silu(float x) { return x / (1.0f + __expf(-x)); }
__device__ __forceinline__ float gelu_tanh(float y) {
    const float v = 0.7978845608028654f * (y + 0.044715f * y * y * y);
    const float th = 1.0f - 2.0f / (__expf(2.0f * v) + 1.0f);
    return 0.5f * y * (1.0f + th);
}
__device__ __forceinline__ float logsig(float x) { return fminf(x, 0.f) - __logf(1.0f + __expf(-fabsf(x))); }
#define LDS_FENCE() asm volatile("s_waitcnt lgkmcnt(0)" ::: "memory")

__device__ __forceinline__ bf16_t* w_gu(unsigned char* ws, int l, int which) { return (bf16_t*)(ws + OFF_W + (size_t)l * SZ_FFN + (size_t)which * (SZ_WGU + SZ_WD)); }
__device__ __forceinline__ bf16_t* w_dn(unsigned char* ws, int l, int which) { return (bf16_t*)(ws + OFF_W + (size_t)l * SZ_FFN + (size_t)which * (SZ_WGU + SZ_WD) + SZ_WGU); }
__device__ __forceinline__ bf16_t* w_abin(unsigned char* ws, int i) { return (bf16_t*)(ws + OFF_WAB + (size_t)i * SZ_AB); }
__device__ __forceinline__ bf16_t* w_glu(unsigned char* ws, int i) { return (bf16_t*)(ws + OFF_WAB + (size_t)i * SZ_AB + SZ_WINAB); }
__device__ __forceinline__ bf16_t* w_about(unsigned char* ws, int i) { return (bf16_t*)(ws + OFF_WAB + (size_t)i * SZ_AB + SZ_WINAB + SZ_WGLU); }
__device__ __forceinline__ bf16_t* w_gin(unsigned char* ws, int i) { return (bf16_t*)(ws + OFF_WG + (size_t)i * SZ_G); }
__device__ __forceinline__ bf16_t* w_gout(unsigned char* ws, int i) { return (bf16_t*)(ws + OFF_WG + (size_t)i * SZ_G + SZ_WING); }

__device__ __forceinline__ void transpose_item(const float* W, int K, int Nsrc, bf16_t* WT, const float* gain, float scale, int mode, float* scr, int item, int nblk, int lane) {
    const int kb = item / nblk, nb = item - kb * nblk, k0 = 64 * kb, n0 = 64 * nb;
    int sc0;
    if (mode == 1) { const int t = n0 >> 8, w = n0 & 255; sc0 = (w < 128) ? (t * 128 + w) : (DFF + t * 128 + (w - 128)); }
    else sc0 = n0;
    const int c4 = lane & 15, kq = lane >> 4;
    const bool valid = (sc0 + 4 * c4) < Nsrc;
    f32x4 v[16];
#pragma unroll
    for (int i = 0; i < 16; ++i) {
        const int kk = kq + 4 * i;
        v[i] = valid ? __builtin_nontemporal_load((const f32x4*)(W + (size_t)(k0 + kk) * Nsrc + sc0 + 4 * c4)) : (f32x4){0.f, 0.f, 0.f, 0.f};
    }
#pragma unroll
    for (int i = 0; i < 16; ++i) {
        const int kk = kq + 4 * i; const float g = gain ? gain[k0 + kk] * scale : scale;
        float* d = scr + kk * 65 + 4 * c4;
        d[0] = v[i][0] * g; d[1] = v[i][1] * g; d[2] = v[i][2] * g; d[3] = v[i][3] * g;
    }
    LDS_FENCE();
    const int c = lane & 7;
#pragma unroll
    for (int j = 0; j < 8; ++j) {
        const int n = (lane >> 3) + 8 * j; const float* s = scr + (8 * c) * 65 + n;
        u32x4 o; o.x = pk2(s[0 * 65], s[1 * 65]); o.y = pk2(s[2 * 65], s[3 * 65]); o.z = pk2(s[4 * 65], s[5 * 65]); o.w = pk2(s[6 * 65], s[7 * 65]);
        *(u32x4*)(WT + (size_t)(n0 + n) * K + k0 + 8 * c) = o;
    }
    LDS_FENCE();
}

__device__ __forceinline__ void phase_prologue(ArgP a, unsigned char* smem, int wg, int G) {
    const int tid = ltid(), lane = tid & 63, wave = tid >> 6;
    const int gw = wg * NWAVES + wave, NGW = G * NWAVES;
    unsigned char* ws = a->ws;
    float* scr = (float*)(smem + wave * 16896);
    for (int mid = 0; mid < 26; ++mid) {
        const float* W; const float* gain = nullptr; bf16_t* WT; int K, Nsrc, Nd, mode = 0; float scale = 1.0f;
        if (mid < 16) {
            const int l = mid >> 2, k = mid & 3;
            if (k == 0)      { W = a->in[I_F1GU] + (size_t)l * DM * NGU; K = DM; Nsrc = NGU; Nd = NGU; gain = a->in[I_NF1] + l * DM; mode = 1; WT = w_gu(ws, l, 0); }
            else if (k == 1) { W = a->in[I_F1D] + (size_t)l * DFF * DM; K = DFF; Nsrc = DM; Nd = DM; scale = 0.5f; WT = w_dn(ws, l, 0); }
            else if (k == 2) { W = a->in[I_F2GU] + (size_t)l * DM * NGU; K = DM; Nsrc = NGU; Nd = NGU; gain = a->in[I_NF2] + l * DM; mode = 1; WT = w_gu(ws, l, 1); }
            else             { W = a->in[I_F2D] + (size_t)l * DFF * DM; K = DFF; Nsrc = DM; Nd = DM; scale = 0.5f; WT = w_dn(ws, l, 1); }
        } else if (mid < 22) {
            const int i = (mid - 16) / 3, k = (mid - 16) % 3;
            if (k == 0)      { W = a->in[I_ABIN] + (size_t)i * DM * NAB; K = DM; Nsrc = NAB; Nd = NAB; gain = a->in[I_NMIX] + (2 * i) * DM; WT = w_abin(ws, i); }
            else if (k == 1) { W = a->in[I_S5GLU] + (size_t)i * 512 * 512; K = 512; Nsrc = 512; Nd = 512; WT = w_glu(ws, i); }
            else             { W = a->in[I_ABOUT] + (size_t)i * DM * DM; K = DM; Nsrc = DM; Nd = DM; WT = w_about(ws, i); }
        } else {
            const int i = (mid - 22) >> 1, k = (mid - 22) & 1;
            if (k == 0)      { W = a->in[I_GIN] + (size_t)i * DM * NGLA; K = DM; Nsrc = NGLA; Nd = NGLAP; gain = a->in[I_NMIX] + (2 * i + 1) * DM; WT = w_gin(ws, i); }
            else             { W = a->in[I_GOUT] + (size_t)i * DM * DM; K = DM; Nsrc = DM; Nd = DM; WT = w_gout(ws, i); }
        }
        const int nblk = Nd / 64, nitems = (K / 64) * nblk;
        int start = gw - (mid * 601) % NGW; if (start < 0) start += NGW;
        for (int it = start; it < nitems; it += NGW) transpose_item(W, K, Nsrc, WT, gain, scale, mode, scr, it, nblk, lane);
    }
    bf16_t* __restrict__ XL = (bf16_t*)(ws + OFF_X); bf16_t* __restrict__ XB = (bf16_t*)(ws + OFF_XB); float* __restrict__ SS = (float*)(ws + OFF_SS);
#pragma unroll 4
    for (int m = gw; m < MPAD; m += NGW) {
        const float* src = nullptr;
        if (m < MP) { const int b = m / LP, t = m - b * LP; src = (t < NMETA) ? a->in[I_META] + (size_t)t * DM : a->in[I_XP] + ((size_t)b * 2048 + (t - NMETA)) * DM; }
        else if (m < MR) src = a->in[I_XS] + (size_t)(m - MP) * DM;
        float s = 0.f;
#pragma unroll
        for (int j = 0; j < 4; ++j) {
            f32x4 v = {0.f, 0.f, 0.f, 0.f};
            if (src) v = *((const f32x4*)src + 64 * j + lane);
            u32x2 w; w.x = pk2(v[0], v[1]); w.y = pk2(v[2], v[3]);
            u32x2 wl; wl.x = pk2(v[0] - blo(w.x), v[1] - bhi(w.x)); wl.y = pk2(v[2] - blo(w.y), v[3] - bhi(w.y));
            *((u32x2*)(XB + (size_t)m * DM) + 64 * j + lane) = w;
            if (RESID_LO) *((u32x2*)(XL + (size_t)m * DM) + 64 * j + lane) = wl;
            s += (v[0] * v[0] + v[1] * v[1]) + (v[2] * v[2] + v[3] * v[3]);
        }
        s = wave_sum(s);
        if (lane < 16) SS[(size_t)m * 16 + lane] = (lane == 0) ? s : 0.f;
    }
    {
        const int gt = wg * NTHR + tid, NT = G * NTHR;
        unsigned* pA = (unsigned*)(ws + OFF_A2 + (size_t)MR * DM * 2); unsigned* pZ = (unsigned*)(ws + OFF_Z + (size_t)MR * 512 * 2); unsigned* pO = (unsigned*)(ws + OFF_O + (size_t)MR * DM * 2);
        for (int i = gt; i < (MPAD - MR) * DM / 2; i += NT) { pA[i] = 0u; pO[i] = 0u; }
        for (int i = gt; i < (MPAD - MR) * 512 / 2; i += NT) pZ[i] = 0u;
        float* RC = (float*)(ws + OFF_ROT); float* RS = RC + NROT * 32;
        for (int i = gt; i < NROT * 32; i += NT) {
            const int idx = i >> 5, f = i & 31; const int pos = (idx < LP) ? idx : (16384 + idx - LP);
            const float inv = 1.0f / powf(10000.0f, (float)f / 32.0f);
            const float ang = (float)pos * inv;
            RC[i] = cosf(ang); RS[i] = sinf(ang);
        }
        for (int i = gt; i < 2 * 32 * 64; i += NT) {
            const int ev = i >> 11, gp = i & 2047, g = gp >> 6;
            float* Ta = (float*)(ws + OFF_S5T) + (size_t)ev * S5T_STRIDE_F; float* Tb = Ta + 32 * 64 * 2;
            const float ar = a->in[I_S5AR][i], ai = a->in[I_S5AI][i];
            const float dt = expf(a->in[I_S5DT][ev * 32 + g]);
            const float mag = expf(dt * ar);
            const float abr = mag * cosf(dt * ai), abi = mag * sinf(dt * ai);
            const float den = ar * ar + ai * ai, nre = abr - 1.0f;
            const float fre = (nre * ar + abi * ai) / den, fim = (abi * ar - nre * ai) / den;
            Ta[gp * 2] = abr; Ta[gp * 2 + 1] = abi;
            const float* br = a->in[I_S5BR] + (size_t)i * 16; const float* bi = a->in[I_S5BI] + (size_t)i * 16;
#pragma unroll
            for (int n = 0; n < 16; ++n) { Tb[gp * 32 + n] = fre * br[n] - fim * bi[n]; Tb[gp * 32 + 16 + n] = fre * bi[n] + fim * br[n]; }
        }
    }
}

typedef float f32x2 __attribute__((ext_vector_type(2)));
#define S5_STEP(t)                                                                                                            \
    { const f32x4 ua = *(const f32x4*)(Us + 16 * (t)), ub = *(const f32x4*)(Us + 16 * (t) + 4), uc = *(const f32x4*)(Us + 16 * (t) + 8), ud = *(const f32x4*)(Us + 16 * (t) + 12); \
      f32x2 xa = Bp[0] * ua[0], xb = Bp[4] * ub[0], xc = Bp[8] * uc[0], xd = Bp[12] * ud[0];       \
      xa = Bp[1] * ua[1] + xa; xb = Bp[5] * ub[1] + xb; xc = Bp[9] * uc[1] + xc; xd = Bp[13] * ud[1] + xd;                       \
      xa = Bp[2] * ua[2] + xa; xb = Bp[6] * ub[2] + xb; xc = Bp[10] * uc[2] + xc; xd = Bp[14] * ud[2] + xd;                      \
      xa = Bp[3] * ua[3] + xa; xb = Bp[7] * ub[3] + xb; xc = Bp[11] * uc[3] + xc; xd = Bp[15] * ud[3] + xd;                      \
      const f32x2 x2 = (xa + xb) + (xc + xd);                                                                                   \
                                         \
      const f32x2 hs = {-h2[1], h2[0]};                                                                                         \
      h2 = ab2[0] * h2 + (ab2[1] * hs + x2); }
constexpr int S5_WAVE_LDS = 16 * 136 * 2 + 16 * 16 * 4;

__device__ __forceinline__ void s5_pass1(ArgP a, int ev, unsigned char* smem, int gw, int NGW, int lane, int wave) {
    float* Us = (float*)(smem + wave * S5_WAVE_LDS + 16 * 136 * 2);
    unsigned char* ws = a->ws;
    const bf16_t* PROJ = (const bf16_t*)(ws + OFF_HP);
    const float* Ta = (const float*)(ws + OFF_S5T) + (size_t)ev * S5T_STRIDE_F; const float* Tb = Ta + 32 * 64 * 2;
    float* E = (float*)(ws + OFF_S5E);
    for (int item = gw; item < 8 * 32 * 16; item += NGW) {
        const int j = item & 15, g = (item >> 4) & 31, b = item >> 9;
        const float abr = Ta[(g * 64 + lane) * 2], abi = Ta[(g * 64 + lane) * 2 + 1];
        f32x2 Bp[16];
#pragma unroll
        for (int q = 0; q < 4; ++q) { const f32x4 vr = *((const f32x4*)(Tb + (size_t)(g * 64 + lane) * 32) + q), vi = *((const f32x4*)(Tb + (size_t)(g * 64 + lane) * 32) + 4 + q);
            Bp[4 * q] = (f32x2){vr[0], vi[0]}; Bp[4 * q + 1] = (f32x2){vr[1], vi[1]}; Bp[4 * q + 2] = (f32x2){vr[2], vi[2]}; Bp[4 * q + 3] = (f32x2){vr[3], vi[3]}; }
        const f32x2 ab2 = {abr, abi};
        f32x2 h2 = {0.f, 0.f};
        const bf16_t* up = PROJ + (size_t)(b * LP + j * 128) * NAB + 16 * g;
        u32x2 raw = *(const u32x2*)(up + (size_t)(lane >> 2) * NAB + 4 * (lane & 3));
        for (int blk = 0; blk < 8; ++blk) {
            LDS_FENCE();
            *(f32x4*)(Us + 4 * lane) = (f32x4){blo(raw.x), bhi(raw.x), blo(raw.y), bhi(raw.y)};
            LDS_FENCE();
            if (blk + 1 < 8) raw = *(const u32x2*)(up + (size_t)((blk + 1) * 16 + (lane >> 2)) * NAB + 4 * (lane & 3));
#pragma unroll
            for (int t = 0; t < 16; ++t) S5_STEP(t)
        }
        float* e = E + ((size_t)((b * 32 + g) * 16 + j)) * 128;
        e[lane] = h2[0]; e[64 + lane] = h2[1];
    }
}

__device__ __forceinline__ void s5_pass2(ArgP a, int ev, unsigned char* smem, int gw, int NGW, int lane, int wave) {
    unsigned char* ws = a->ws;
    const bf16_t* PROJ = (const bf16_t*)(ws + OFF_HP);
    bf16_t* Z = (bf16_t*)(ws + OFF_Z);
    const float* Ta = (const float*)(ws + OFF_S5T) + (size_t)ev * S5T_STRIDE_F; const float* Tb = Ta + 32 * 64 * 2;
    const float* E = (const float*)(ws + OFF_S5E);
    bf16_t* Hs = (bf16_t*)(smem + wave * S5_WAVE_LDS);
    float* Us = (float*)(smem + wave * S5_WAVE_LDS + 16 * 136 * 2);
    const int fr = lane & 15, fq = lane >> 4;
    constexpr int NPI = 8 * 32 * 17, NSI = 128 * 32;
    for (int item = gw; item < NPI + NSI; item += NGW) {
        int b, g, j, nblk, nvalid; size_t row0; bool prompt = item < NPI;
        if (prompt) { int bg; if (item < 4096) { j = item & 15; bg = item >> 4; } else { j = 16; bg = item - 4096; }
            g = bg & 31; b = bg >> 5; nblk = (j < 16) ? 8 : 1; nvalid = 16; row0 = (size_t)b * LP + j * 128; }
        else { const int it = item - NPI; g = it & 31; b = it >> 5; j = 0; nblk = 1; nvalid = 8; row0 = (size_t)MP + b * 8; }
        const float abr = Ta[(g * 64 + lane) * 2], abi = Ta[(g * 64 + lane) * 2 + 1];
        f32x2 Bp[16];
#pragma unroll
        for (int q = 0; q < 4; ++q) { const f32x4 vr = *((const f32x4*)(Tb + (size_t)(g * 64 + lane) * 32) + q), vi = *((const f32x4*)(Tb + (size_t)(g * 64 + lane) * 32) + 4 + q);
            Bp[4 * q] = (f32x2){vr[0], vi[0]}; Bp[4 * q + 1] = (f32x2){vr[1], vi[1]}; Bp[4 * q + 2] = (f32x2){vr[2], vi[2]}; Bp[4 * q + 3] = (f32x2){vr[3], vi[3]}; }
        const f32x2 ab2 = {abr, abi};
        bf16x8 Cf[4];
        {
            const float* cr = a->in[I_S5CR] + ((size_t)(ev * 32 + g) * 16 + fr) * 64; const float* ci = a->in[I_S5CI] + ((size_t)(ev * 32 + g) * 16 + fr) * 64;
#pragma unroll
            for (int kb = 0; kb < 4; ++kb) {
                const float* p = (kb < 2) ? (cr + 32 * kb + 8 * fq) : (ci + 32 * (kb - 2) + 8 * fq); const float sg = (kb < 2) ? 1.f : -1.f;
                const f32x4 v0 = *(const f32x4*)p, v1 = *(const f32x4*)(p + 4);
                u32x4 w; w.x = pk2(sg * v0[0], sg * v0[1]); w.y = pk2(sg * v0[2], sg * v0[3]); w.z = pk2(sg * v1[0], sg * v1[1]); w.w = pk2(sg * v1[2], sg * v1[3]);
                Cf[kb] = __builtin_bit_cast(bf16x8, w);
            }
        }
        const float dsk = a->in[I_S5D][ev * 512 + 16 * g + fr];
        float hr = 0.f, hi = 0.f;
        if (prompt) {
            float pr = abr, pi = abi;
#pragma unroll
            for (int s = 0; s < 7; ++s) { const float tr = pr * pr - pi * pi, ti = 2.f * pr * pi; pr = tr; pi = ti; }
            const float* e = E + ((size_t)((b * 32 + g) * 16)) * 128;
            float er[16], ei[16];
#pragma unroll
            for (int jj = 0; jj < 16; ++jj) { er[jj] = 0.f; ei[jj] = 0.f; if (jj < j) { er[jj] = e[jj * 128 + lane]; ei[jj] = e[jj * 128 + 64 + lane]; } }
#pragma unroll
            for (int jj = 0; jj < 16; ++jj) if (jj < j) { const float nr = pr * hr - pi * hi + er[jj], ni = pr * hi + pi * hr + ei[jj]; hr = nr; hi = ni; }
        } else {
            hr = a->in[I_S5R][((size_t)(ev * 128 + b) * 32 + g) * 64 + lane]; hi = a->in[I_S5I][((size_t)(ev * 128 + b) * 32 + g) * 64 + lane];
        }
        float fhr = 0.f, fhi = 0.f;
        f32x2 h2 = {hr, hi};
        const int tl = lane >> 2;
        u32x2 raw = {0u, 0u};
        if (tl < nvalid) raw = *(const u32x2*)(PROJ + (row0 + tl) * NAB + 16 * g + 4 * (lane & 3));
        for (int blk = 0; blk < nblk; ++blk) {
            const size_t rb = row0 + blk * 16;
            *(f32x4*)(Us + 4 * lane) = (f32x4){blo(raw.x), bhi(raw.x), blo(raw.y), bhi(raw.y)};
            LDS_FENCE();
            if (blk + 1 < nblk) raw = *(const u32x2*)(PROJ + (rb + 16 + tl) * NAB + 16 * g + 4 * (lane & 3));
#pragma unroll
            for (int t = 0; t < 16; ++t) {
                S5_STEP(t)
                const unsigned hb = pg8::cvt_pk_bf16(h2[0], h2[1]);
                Hs[t * 136 + lane] = (bf16_t)(hb & 0xffffu); Hs[t * 136 + 64 + lane] = (bf16_t)(hb >> 16);
                if (t == 7) { fhr = h2[0]; fhi = h2[1]; }
            }
            LDS_FENCE();
            f32x4 acc = {0.f, 0.f, 0.f, 0.f};
#pragma unroll
            for (int kb = 0; kb < 4; ++kb) {
                const bf16x8 af = *(const bf16x8*)(Hs + fr * 136 + 32 * kb + 8 * fq);
                acc = __builtin_amdgcn_mfma_f32_16x16x32_bf16(af, Cf[kb], acc, 0, 0, 0);
            }
            LDS_FENCE();
#pragma unroll
            for (int e = 0; e < 4; ++e) {
                const int t = 4 * fq + e;
                if (t < nvalid) {
                    const float uv = Us[16 * t + fr];
                    const float y = acc[e] + dsk * uv;
                    Z[(rb + t) * 512 + 16 * g + fr] = f2bf(gelu_tanh(y));
                }
            }
        }
        if (prompt) {
            if (j == 16) { a->out[OUT_PS5R + ((size_t)(ev * 8 + b) * 32 + g) * 64 + lane] = h2[0]; a->out[OUT_PS5I + ((size_t)(ev * 8 + b) * 32 + g) * 64 + lane] = h2[1]; }
        } else {
            a->out[OUT_SS5R + ((size_t)(ev * 128 + b) * 32 + g) * 64 + lane] = fhr; a->out[OUT_SS5I + ((size_t)(ev * 128 + b) * 32 + g) * 64 + lane] = fhi;
        }
    }
}

constexpr int NCH = 33, NPITEM = NB * 4 * NCH;
template <int DK> __device__ __forceinline__ bf16_t* prep_q(unsigned char* ws, int item) { return (bf16_t*)(ws + OFF_A2) + (size_t)item * 64 * DK; }
template <int DK> __device__ __forceinline__ bf16_t* prep_k(unsigned char* ws, int item) { return (bf16_t*)(ws + OFF_A2) + (size_t)NPITEM * 64 * DK + (size_t)item * 64 * DK; }
__device__ __forceinline__ bf16_t* prep_p(unsigned char* ws, int item) { return (bf16_t*)(ws + OFF_PART) + (size_t)item * 64 * 64; }
__device__ __forceinline__ float* prep_a(unsigned char* ws, int item) { return (float*)(ws + OFF_S5E) + (size_t)item * 128; }

template <int DK, bool GLA>
__device__ __forceinline__ void la_prep(ArgP a, int li, unsigned char* smem, int wg, int G) {
    constexpr int C = 64, LDQ = DK + 8, LDT = C + 8, LDP = GLA ? NGLAP : NAB;
    unsigned char* ws = a->ws;
    const bf16_t* PROJ = (const bf16_t*)(ws + OFF_HP);
    bf16_t* Qt = (bf16_t*)smem;
    bf16_t* Kt = Qt + C * LDQ;
    bf16_t* KhT = Kt + C * LDQ;
    bf16_t* Pb = KhT + DK * LDT;
    float* aS = (float*)(Pb + C * LDT);
    float* Bc = aS + DK;
    float* LR = Bc + (GLA ? C * DK : 0);
    const int tid = ltid(), lane = tid & 63, w = tid >> 6, fr = lane & 15, fq = lane >> 4;
    const float* RC = (const float*)(ws + OFF_ROT); const float* RS = RC + NROT * 32;
    for (int item = wg; item < NPITEM; item += G) {
        const int c = item % NCH, h = (item / NCH) & 3, b = item / (NCH * 4);
        const size_t rowc = (size_t)b * LP + 64 * c;
        const int nv = (c < 32) ? 64 : 16;
        __syncthreads();
        if constexpr (GLA) {
            const int grp = tid >> 7, d = tid & 127;
            float wa[16];
#pragma unroll
            for (int n = 0; n < 16; ++n) wa[n] = a->in[I_GA2][((size_t)li * 16 + n) * 512 + h * 128 + d];
            const float bias = a->in[I_GBA][li * 512 + h * 128 + d];
#pragma unroll
            for (int r = 0; r < 2; ++r) { const int e = tid + r * 512, t = e >> 4, n = e & 15; LR[e] = (t < nv) ? bf2f(PROJ[(rowc + t) * LDP + 3072 + n]) : 0.f; }
            float qv[16], kv[16];
#pragma unroll
            for (int tl = 0; tl < 16; ++tl) {
                const int t = 16 * grp + tl; qv[tl] = 0.f; kv[tl] = 0.f;
                if (t < nv) { qv[tl] = bf2f(PROJ[(rowc + t) * LDP + 128 * h + d]); kv[tl] = bf2f(PROJ[(rowc + t) * LDP + 512 + 128 * h + d]) * 0.08838834764831845f; }
            }
            __syncthreads();
            float bl[16];
            {
                float cum = 0.f;
#pragma unroll
                for (int tl = 0; tl < 16; ++tl) {
                    const int t = 16 * grp + tl; float x = bias;
#pragma unroll
                    for (int n = 0; n < 16; ++n) x = fmaf(LR[t * 16 + n], wa[n], x);
                    const float la = (t < nv) ? logsig(x) * (1.0f / 16.0f) : 0.f;
                    cum += la; bl[tl] = cum;
                }
                Bc[grp * DK + d] = cum;
            }
            __syncthreads();
            {
                float off = 0.f, blast = 0.f;
#pragma unroll
                for (int gg = 0; gg < 4; ++gg) { const float v = Bc[gg * DK + d]; blast += v; if (gg < grp) off += v; }
#pragma unroll
                for (int tl = 0; tl < 16; ++tl) {
                    const int t = 16 * grp + tl; const float bb = bl[tl] + off;
                    Qt[t * LDQ + d] = f2bf(qv[tl] * __expf(bb)); Kt[t * LDQ + d] = f2bf(kv[tl] * __expf(-bb)); KhT[d * LDT + t] = f2bf(kv[tl] * __expf(blast - bb));
                }
                if (grp == 0) aS[d] = __expf(blast);
            }
        } else {
            const float lg = logf(1.0f - exp2f(-5.0f - (float)h));
            const int t = tid >> 3, dg = tid & 7; const int pos = 64 * c + t;
            u32x2 ql = {0u, 0u}, qh = {0u, 0u}, kl = {0u, 0u}, kh = {0u, 0u};
            f32x4 cs = {1.f, 1.f, 1.f, 1.f}, sn = {0.f, 0.f, 0.f, 0.f};
            if (t < nv) {
                const bf16_t* pr = PROJ + (rowc + t) * LDP;
                ql = *(const u32x2*)(pr + 512 + 64 * h + 4 * dg); qh = *(const u32x2*)(pr + 512 + 64 * h + 32 + 4 * dg);
                kl = *(const u32x2*)(pr + 768 + 64 * h + 4 * dg); kh = *(const u32x2*)(pr + 768 + 64 * h + 32 + 4 * dg);
                cs = *(const f32x4*)(RC + (size_t)pos * 32 + 4 * dg); sn = *(const f32x4*)(RS + (size_t)pos * 32 + 4 * dg);
            }
            const int te = (t < nv) ? (t + 1) : nv;
            const float bt = (float)te * lg, blast = (float)nv * lg;
            const float eq = __expf(bt), ek = 0.125f * __expf(-bt), ekh = 0.125f * __expf(blast - bt);
            const float q1[4] = {blo(ql.x), bhi(ql.x), blo(ql.y), bhi(ql.y)}, q2[4] = {blo(qh.x), bhi(qh.x), blo(qh.y), bhi(qh.y)};
            const float k1[4] = {blo(kl.x), bhi(kl.x), blo(kl.y), bhi(kl.y)}, k2[4] = {blo(kh.x), bhi(kh.x), blo(kh.y), bhi(kh.y)};
#pragma unroll
            for (int x = 0; x < 4; ++x) {
                const int d = 4 * dg + x;
                const float qa = q1[x] * cs[x] - q2[x] * sn[x], qb = q1[x] * sn[x] + q2[x] * cs[x];
                const float ka = k1[x] * cs[x] - k2[x] * sn[x], kb = k1[x] * sn[x] + k2[x] * cs[x];
                Qt[t * LDQ + d] = f2bf(qa * eq); Qt[t * LDQ + d + 32] = f2bf(qb * eq);
                Kt[t * LDQ + d] = f2bf(ka * ek); Kt[t * LDQ + d + 32] = f2bf(kb * ek);
                KhT[d * LDT + t] = f2bf(ka * ekh); KhT[(d + 32) * LDT + t] = f2bf(kb * ekh);
            }
        }
        __syncthreads();
        {
            const int ptt = w >> 1;
#pragma unroll
            for (int s2 = 0; s2 < 2; ++s2) {
                const int st = 2 * (w & 1) + s2;
                f32x4 p = {0.f, 0.f, 0.f, 0.f};
                if (st <= ptt) {
#pragma unroll
                    for (int kb = 0; kb < DK / 32; ++kb) {
                        const bf16x8 af = *(const bf16x8*)(Qt + (16 * ptt + fr) * LDQ + 32 * kb + 8 * fq);
                        const bf16x8 bfg = *(const bf16x8*)(Kt + (16 * st + fr) * LDQ + 32 * kb + 8 * fq);
                        p = __builtin_amdgcn_mfma_f32_16x16x32_bf16(af, bfg, p, 0, 0, 0);
                    }
                }
#pragma unroll
                for (int e = 0; e < 4; ++e) { const int t = 16 * ptt + 4 * fq + e, s = 16 * st + fr; Pb[t * LDT + s] = (s <= t) ? f2bf(p[e]) : (bf16_t)0; }
            }
        }
        __syncthreads();
        bf16_t* qg = prep_q<DK>(ws, item); bf16_t* kg = prep_k<DK>(ws, item); bf16_t* pg = prep_p(ws, item);
#pragma unroll
        for (int r = 0; r < DK / 64; ++r) {
            const int e = tid + r * 512;
            { const int t = e / (DK / 8), cc = e % (DK / 8); *(u32x4*)(qg + t * DK + 8 * cc) = *(const u32x4*)(Qt + t * LDQ + 8 * cc); }
            { const int d = e >> 3, cc = e & 7; *(u32x4*)(kg + d * 64 + 8 * cc) = *(const u32x4*)(KhT + d * LDT + 8 * cc); }
        }
        { const int t = tid >> 3, cc = tid & 7; *(u32x4*)(pg + t * 64 + 8 * cc) = *(const u32x4*)(Pb + t * LDT + 8 * cc); }
        if constexpr (GLA) { if (tid < DK) prep_a(ws, item)[tid] = aS[tid]; }
    }
}

template <int DK, int DV, int DVS, bool GLA>
__device__ __forceinline__ void la_prompt(ArgP a, int li, unsigned char* smem, int wg, int G) {
    constexpr int C = 64, NSL = DV / DVS, NTM = DVS / 16, NTN = DK / 16, LDQ = DK + 8, LDT = C + 8, LDP = GLA ? NGLAP : NAB, LDO = 4 * DV, NR = DK / 64;
    static_assert(NTM == 1 || NTM == 2, "dv tiles per slice");
    unsigned char* ws = a->ws;
    const bf16_t* PROJ = (const bf16_t*)(ws + OFF_HP);
    bf16_t* OB = (bf16_t*)(ws + OFF_O);
    constexpr int BUF_ELEMS = C * LDQ + DK * LDT + DVS * LDT + C * LDT + DVS * LDQ + 2 * DK;
    static_assert((BUF_ELEMS * 2) % 16 == 0 && 2 * BUF_ELEMS * 2 <= RING_BYTES, "la_prompt LDS");
    const int tid = ltid(), lane = tid & 63, w = tid >> 6, fr = lane & 15, fq = lane >> 4;
    const int tt = (NTM == 2) ? (w >> 1) : (w & 3), dt = (NTM == 2) ? (w & 1) : 0;
    const bool has_o = (NTM == 2) || (w < 4);
    const bool has_v = GLA || (tid < 256);
    const int vt = GLA ? (tid >> 3) : (tid >> 2), vj4 = GLA ? ((tid & 7) * 4) : ((tid & 3) * 4);
    for (int item0 = wg; item0 < NB * 4 * NSL; item0 += G) {
        const int item = (G == NB * 4 * NSL && (G & 7) == 0) ? (item0 & 7) * (G >> 3) + (item0 >> 3) : item0;
        const int sl = item % NSL, h = (item / NSL) & 3, b = item / (NSL * 4);
        const int pit0 = (b * 4 + h) * NCH;
        const float lg = GLA ? 0.f : logf(1.0f - exp2f(-5.0f - (float)h));
        f32x4 sacc[NTM];
#pragma unroll
        for (int m = 0; m < NTM; ++m) sacc[m] = (f32x4){0.f, 0.f, 0.f, 0.f};
        u32x4 rq0[NR], rk0[NR], rp0, rq1[NR], rk1[NR], rp1; u32x2 rv0 = {0u, 0u}, rv1 = {0u, 0u}; float ra0 = 0.f, ra1 = 0.f;
#define LA_PREFETCH(S_, cc_) do { const int c_ = (cc_); const int nv_ = (c_ < 32) ? 64 : 16; const size_t rowc_ = (size_t)b * LP + 64 * c_; \
            const bf16_t* qg = prep_q<DK>(ws, pit0 + c_); const bf16_t* kg = prep_k<DK>(ws, pit0 + c_); const bf16_t* pg = prep_p(ws, pit0 + c_); \
            _Pragma("unroll") for (int r = 0; r < NR; ++r) { rq##S_[r] = *(const u32x4*)(qg + (size_t)(tid + r * 512) * 8); rk##S_[r] = *(const u32x4*)(kg + (size_t)(tid + r * 512) * 8); } \
            rp##S_ = *(const u32x4*)(pg + (size_t)tid * 8); \
            if (GLA) { if (tid < DK) ra##S_ = prep_a(ws, pit0 + c_)[tid]; } else ra##S_ = __expf((float)nv_ * lg); \
            rv##S_ = (u32x2){0u, 0u}; if (has_v && vt < nv_) rv##S_ = *(const u32x2*)(PROJ + (rowc_ + vt) * LDP + 1024 + DV * h + DVS * sl + vj4); } while (0)
#define LA_BUF(par_) bf16_t* Qt = (bf16_t*)smem + (par_) * BUF_ELEMS; bf16_t* KhT = Qt + C * LDQ; bf16_t* VT = KhT + DK * LDT; bf16_t* Pb = VT + DVS * LDT; bf16_t* ST = Pb + C * LDT; float* aS = (float*)(ST + DVS * LDQ);
#define LA_STAGE(S_, par_) do { LA_BUF(par_) (void)ST; \
            _Pragma("unroll") for (int r = 0; r < NR; ++r) { const int e = tid + r * 512; \
                { const int t = e / (DK / 8), cc = e % (DK / 8); *(u32x4*)(Qt + t * LDQ + 8 * cc) = rq##S_[r]; } \
                { const int d = e >> 3, cc = e & 7; *(u32x4*)(KhT + d * LDT + 8 * cc) = rk##S_[r]; } } \
            { const int t = tid >> 3, cc = tid & 7; *(u32x4*)(Pb + t * LDT + 8 * cc) = rp##S_; } \
            if (tid < DK) aS[tid] = ra##S_; \
            if (has_v) { VT[(vj4 + 0) * LDT + vt] = (bf16_t)(rv##S_.x & 0xffffu); VT[(vj4 + 1) * LDT + vt] = (bf16_t)(rv##S_.x >> 16); \
                         VT[(vj4 + 2) * LDT + vt] = (bf16_t)(rv##S_.y & 0xffffu); VT[(vj4 + 3) * LDT + vt] = (bf16_t)(rv##S_.y >> 16); } } while (0)
#define LA_CHUNK(S_, c_expr) do { const int c = (c_expr); const size_t rowc = (size_t)b * LP + 64 * c; const int nv = (c < 32) ? 64 : 16; \
            __syncthreads(); \
            if (c + 1 < NCH) LA_STAGE(S_, (c + 1) & 1); \
            if (c + 3 < NCH) LA_PREFETCH(S_, c + 3); \
            LA_BUF(c & 1) \
            if (has_o) { \
                f32x4 o = {0.f, 0.f, 0.f, 0.f}; \
                _Pragma("unroll") for (int kb = 0; kb < DK / 32; ++kb) { \
                    const bf16x8 af = *(const bf16x8*)(Qt + (16 * tt + fr) * LDQ + 32 * kb + 8 * fq); \
                    const bf16x8 bfg = *(const bf16x8*)(ST + (16 * dt + fr) * LDQ + 32 * kb + 8 * fq); \
                    o = __builtin_amdgcn_mfma_f32_16x16x32_bf16(af, bfg, o, 0, 0, 0); } \
                _Pragma("unroll") for (int kb = 0; kb < 2; ++kb) { \
                    const bf16x8 af = *(const bf16x8*)(Pb + (16 * tt + fr) * LDT + 32 * kb + 8 * fq); \
                    const bf16x8 bfg = *(const bf16x8*)(VT + (16 * dt + fr) * LDT + 32 * kb + 8 * fq); \
                    o = __builtin_amdgcn_mfma_f32_16x16x32_bf16(af, bfg, o, 0, 0, 0); } \
                _Pragma("unroll") for (int e = 0; e < 4; ++e) { const int t = 16 * tt + 4 * fq + e; if (t < nv) OB[(rowc + t) * LDO + h * DV + DVS * sl + 16 * dt + fr] = f2bf(o[e]); } \
            } \
            if (w < NTN) { \
                const float av = aS[16 * w + fr]; \
                bf16_t* STn = (bf16_t*)smem + ((c + 1) & 1) * BUF_ELEMS + C * LDQ + DK * LDT + DVS * LDT + C * LDT; \
                _Pragma("unroll") for (int m = 0; m < NTM; ++m) { \
                    f32x4 s_ = sacc[m] * av; \
                    _Pragma("unroll") for (int kb = 0; kb < 2; ++kb) { \
                        const bf16x8 af = *(const bf16x8*)(VT + (16 * m + fr) * LDT + 32 * kb + 8 * fq); \
                        const bf16x8 bfg = *(const bf16x8*)(KhT + (16 * w + fr) * LDT + 32 * kb + 8 * fq); \
                        s_ = __builtin_amdgcn_mfma_f32_16x16x32_bf16(af, bfg, s_, 0, 0, 0); } \
                    sacc[m] = s_; \
                    _Pragma("unroll") for (int e = 0; e < 4; ++e) STn[(16 * m + 4 * fq + e) * LDQ + 16 * w + fr] = f2bf(s_[e]); } \
            } } while (0)
        __syncthreads();
        LA_PREFETCH(0, 0);
        LA_STAGE(0, 0);
        { LA_BUF(0) (void)Qt; (void)KhT; (void)VT; (void)Pb; (void)aS;
          if (w < NTN) {
#pragma unroll
              for (int m = 0; m < NTM; ++m)
#pragma unroll
                  for (int e = 0; e < 4; ++e) ST[(16 * m + 4 * fq + e) * LDQ + 16 * w + fr] = (bf16_t)0;
          } }
        LA_PREFETCH(1, 1);
        LA_PREFETCH(0, 2);
        for (int c2 = 0; c2 < NCH; c2 += 2) {
            LA_CHUNK(1, c2);
            if (c2 + 1 < NCH) LA_CHUNK(0, c2 + 1);
        }
#undef LA_CHUNK
#undef LA_BUF
#undef LA_STAGE
#undef LA_PREFETCH
        if (w < NTN) {
            float* so = a->out + (GLA ? OUT_PGLA : OUT_PRET) + (((size_t)(li * NB + b) * 4 + h) * DK + 16 * w + fr) * DV + DVS * sl;
#pragma unroll
            for (int m = 0; m < NTM; ++m) __builtin_nontemporal_store(sacc[m], (f32x4*)(so + 16 * m + 4 * fq));
        }
    }
}

template <int DK, int DV, bool GLA>
__device__ __forceinline__ void la_sample(ArgP a, int li, unsigned char* smem, int wg, int G) {
    constexpr int NJ4 = DV / 4, NG = NTHR / NJ4, RPG = DK / NG, LDP = GLA ? NGLAP : NAB, LDO = 4 * DV;
    unsigned char* ws = a->ws;
    const bf16_t* PROJ = (const bf16_t*)(ws + OFF_HP);
    bf16_t* OB = (bf16_t*)(ws + OFF_O);
    float* QK = (float*)smem;
    float* Kts = QK + DK * 16;
    float* Qts = Kts + 8 * DK;
    float* As = Qts + 8 * DK;
    float* Vs = As + DK;
    float* Ps = Vs + 8 * DV;
    float* Ored = Ps + 64;
    float* LR = Ored + NG * 8 * DV;
    const int tid = ltid();
    const float* RC = (const float*)(ws + OFF_ROT); const float* RS = RC + NROT * 32;
    const float* S0base = a->in[GLA ? I_SGLA : I_SRET]; float* S1base = a->out + (GLA ? OUT_SGLA : OUT_SRET);
    for (int item = wg; item < NSB * 4; item += G) {
        const int b = item >> 2, h = item & 3;
        const size_t row0 = (size_t)MP + b * 8;
        __syncthreads();
        for (int e = tid; e < 8 * DV; e += NTHR) { const int t = e / DV, j = e % DV; Vs[e] = bf2f(PROJ[(row0 + t) * LDP + 1024 + h * DV + j]); }
        if constexpr (GLA) {
            if (tid < 128) LR[tid] = bf2f(PROJ[(row0 + (tid >> 4)) * LDP + 3072 + (tid & 15)]);
            __syncthreads();
            if (tid < DK) {
                const int d = tid; float bt[8]; float cum = 0.f;
                const float bias = a->in[I_GBA][li * 512 + h * 128 + d];
                float wa[16];
#pragma unroll
                for (int n = 0; n < 16; ++n) wa[n] = a->in[I_GA2][((size_t)li * 16 + n) * 512 + h * 128 + d];
#pragma unroll
                for (int t = 0; t < 8; ++t) {
                    float x = bias;
#pragma unroll
                    for (int n = 0; n < 16; ++n) x = fmaf(LR[t * 16 + n], wa[n], x);
                    cum += logsig(x) * (1.0f / 16.0f); bt[t] = cum;
                }
#pragma unroll
                for (int t = 0; t < 8; ++t) {
                    const float q = bf2f(PROJ[(row0 + t) * LDP + 128 * h + d]);
                    const float k = bf2f(PROJ[(row0 + t) * LDP + 512 + 128 * h + d]) * 0.08838834764831845f;
                    const float qt = q * __expf(bt[t]);
                    QK[d * 16 + t] = qt; QK[d * 16 + 8 + t] = k * __expf(bt[7] - bt[t]); Kts[t * DK + d] = k * __expf(-bt[t]); Qts[t * DK + d] = qt;
                }
                As[d] = __expf(bt[7]);
            }
        } else {
            if (tid < 256) {
                const int t = tid >> 5, d = tid & 31;
                const float lg = logf(1.0f - exp2f(-5.0f - (float)h));
                const bf16_t* pr = PROJ + (row0 + t) * LDP;
                const float q1 = bf2f(pr[512 + 64 * h + d]), q2 = bf2f(pr[512 + 64 * h + 32 + d]), k1 = bf2f(pr[768 + 64 * h + d]), k2 = bf2f(pr[768 + 64 * h + 32 + d]);
                const float cs = RC[(size_t)(LP + t) * 32 + d], sn = RS[(size_t)(LP + t) * 32 + d];
                const float qa = q1 * cs - q2 * sn, qb = q1 * sn + q2 * cs, ka = k1 * cs - k2 * sn, kb = k1 * sn + k2 * cs;
                const float bt = (float)(t + 1) * lg;
                const float eq = __expf(bt), ek = 0.125f * __expf(-bt), ekh = 0.125f * __expf(8.0f * lg - bt);
                QK[d * 16 + t] = qa * eq; QK[(d + 32) * 16 + t] = qb * eq; QK[d * 16 + 8 + t] = ka * ekh; QK[(d + 32) * 16 + 8 + t] = kb * ekh;
                Kts[t * DK + d] = ka * ek; Kts[t * DK + d + 32] = kb * ek; Qts[t * DK + d] = qa * eq; Qts[t * DK + d + 32] = qb * eq;
                if (tid < DK) As[tid] = __expf(8.0f * lg);
            }
        }
        __syncthreads();
        if (tid < 64) {
            const int t = tid >> 3, s = tid & 7; float p = 0.f;
            if (s <= t) { for (int d = 0; d < DK; ++d) p = fmaf(Qts[t * DK + d], Kts[s * DK + d], p); }
            Ps[tid] = p;
        }
        const int grp = tid / NJ4, j4 = (tid % NJ4) * 4;
        const float* S0 = S0base + ((size_t)(li * NSB + b) * 4 + h) * DK * DV; float* S1 = S1base + ((size_t)(li * NSB + b) * 4 + h) * DK * DV;
        f32x4 s0[RPG];
#pragma unroll
        for (int ii = 0; ii < RPG; ++ii) s0[ii] = __builtin_nontemporal_load((const f32x4*)(S0 + (size_t)(grp * RPG + ii) * DV + j4));
        f32x4 vj[8], oa[8];
#pragma unroll
        for (int s2 = 0; s2 < 8; ++s2) { vj[s2] = *(const f32x4*)(Vs + s2 * DV + j4); oa[s2] = (f32x4){0.f, 0.f, 0.f, 0.f}; }
#pragma unroll
        for (int ii = 0; ii < RPG; ++ii) {
            const int i = grp * RPG + ii;
            const f32x4 qa = *(const f32x4*)(QK + i * 16), qb = *(const f32x4*)(QK + i * 16 + 4), ka = *(const f32x4*)(QK + i * 16 + 8), kb = *(const f32x4*)(QK + i * 16 + 12);
            const f32x4 sv = s0[ii];
            oa[0] = sv * qa[0] + oa[0]; oa[1] = sv * qa[1] + oa[1]; oa[2] = sv * qa[2] + oa[2]; oa[3] = sv * qa[3] + oa[3];
            oa[4] = sv * qb[0] + oa[4]; oa[5] = sv * qb[1] + oa[5]; oa[6] = sv * qb[2] + oa[6]; oa[7] = sv * qb[3] + oa[7];
            f32x4 sn = sv * As[i];
            sn = vj[0] * ka[0] + sn; sn = vj[1] * ka[1] + sn; sn = vj[2] * ka[2] + sn; sn = vj[3] * ka[3] + sn;
            sn = vj[4] * kb[0] + sn; sn = vj[5] * kb[1] + sn; sn = vj[6] * kb[2] + sn; sn = vj[7] * kb[3] + sn;
            __builtin_nontemporal_store(sn, (f32x4*)(S1 + (size_t)i * DV + j4));
        }
#pragma unroll
        for (int t = 0; t < 8; ++t) *(f32x4*)(Ored + (grp * 8 + t) * DV + j4) = oa[t];
        __syncthreads();
        for (int e = tid; e < 8 * NJ4; e += NTHR) {
            const int t = e / NJ4, jj = (e % NJ4) * 4; f32x4 o = {0.f, 0.f, 0.f, 0.f};
#pragma unroll
            for (int g2 = 0; g2 < NG; ++g2) o = o + *(const f32x4*)(Ored + (g2 * 8 + t) * DV + jj);
#pragma unroll
            for (int s2 = 0; s2 < 8; ++s2) o = *(const f32x4*)(Vs + s2 * DV + jj) * Ps[t * 8 + s2] + o;
            u32x2 wv; wv.x = pk2(o[0], o[1]); wv.y = pk2(o[2], o[3]);
            *(u32x2*)(OB + (row0 + t) * LDO + h * DV + jj) = wv;
        }
    }
}

__device__ __forceinline__ void ret_finalize(ArgP a, int gw, int NGW, int lane) {
    unsigned char* ws = a->ws;
    const bf16_t* __restrict__ PROJ = (const bf16_t*)(ws + OFF_HP); const bf16_t* __restrict__ OB = (const bf16_t*)(ws + OFF_O); bf16_t* __restrict__ A2 = (bf16_t*)(ws + OFF_A2);
#pragma unroll 4
    for (int m = gw; m < MR; m += NGW) {
        const u32x4 ow = *((const u32x4*)(OB + (size_t)m * 512) + lane);
        const u32x4 gwd = *((const u32x4*)(PROJ + (size_t)m * NAB + 1536) + lane);
        float o[8] = {blo(ow.x), bhi(ow.x), blo(ow.y), bhi(ow.y), blo(ow.z), bhi(ow.z), blo(ow.w), bhi(ow.w)};
        float g[8] = {blo(gwd.x), bhi(gwd.x), blo(gwd.y), bhi(gwd.y), blo(gwd.z), bhi(gwd.z), blo(gwd.w), bhi(gwd.w)};
        float s = 0.f;
#pragma unroll
        for (int i = 0; i < 8; ++i) s += o[i];
        s += __shfl_xor(s, 1); s += __shfl_xor(s, 2); s += __shfl_xor(s, 4); s += __shfl_xor(s, 8);
        const float mu = s * (1.0f / 128.0f); float q = 0.f;
#pragma unroll
        for (int i = 0; i < 8; ++i) { o[i] -= mu; q += o[i] * o[i]; }
        q += __shfl_xor(q, 1); q += __shfl_xor(q, 2); q += __shfl_xor(q, 4); q += __shfl_xor(q, 8);
        const float rs = rsqrtf(q * (1.0f / 128.0f) + 1e-6f);
        u32x4 w;
        w.x = pk2(o[0] * rs * silu(g[0]), o[1] * rs * silu(g[1])); w.y = pk2(o[2] * rs * silu(g[2]), o[3] * rs * silu(g[3]));
        w.z = pk2(o[4] * rs * silu(g[4]), o[5] * rs * silu(g[5])); w.w = pk2(o[6] * rs * silu(g[6]), o[7] * rs * silu(g[7]));
        *((u32x4*)(A2 + (size_t)m * DM + 512) + lane) = w;
    }
}
__device__ __forceinline__ void gla_finalize(ArgP a, int li, int gw, int NGW, int lane) {
    unsigned char* ws = a->ws;
    const bf16_t* __restrict__ PROJ = (const bf16_t*)(ws + OFF_HP); const bf16_t* __restrict__ OB = (const bf16_t*)(ws + OFF_O); bf16_t* __restrict__ A2 = (bf16_t*)(ws + OFF_A2);
    const float* ng = a->in[I_GNORM] + li * 256 + 16 * (lane & 15);
    float gn[16];
#pragma unroll
    for (int i = 0; i < 16; ++i) gn[i] = ng[i];
#pragma unroll 4
    for (int m = gw; m < MR; m += NGW) {
        const u32x4 o0 = *((const u32x4*)(OB + (size_t)m * DM) + 2 * lane), o1 = *((const u32x4*)(OB + (size_t)m * DM) + 2 * lane + 1);
        const u32x4 r0 = *((const u32x4*)(PROJ + (size_t)m * NGLAP + 2048) + 2 * lane), r1 = *((const u32x4*)(PROJ + (size_t)m * NGLAP + 2048) + 2 * lane + 1);
        float o[16] = {blo(o0.x), bhi(o0.x), blo(o0.y), bhi(o0.y), blo(o0.z), bhi(o0.z), blo(o0.w), bhi(o0.w), blo(o1.x), bhi(o1.x), blo(o1.y), bhi(o1.y), blo(o1.z), bhi(o1.z), blo(o1.w), bhi(o1.w)};
        float r[16] = {blo(r0.x), bhi(r0.x), blo(r0.y), bhi(r0.y), blo(r0.z), bhi(r0.z), blo(r0.w), bhi(r0.w), blo(r1.x), bhi(r1.x), blo(r1.y), bhi(r1.y), blo(r1.z), bhi(r1.z), blo(r1.w), bhi(r1.w)};
        float q = 0.f;
#pragma unroll
        for (int i = 0; i < 16; ++i) q += o[i] * o[i];
        q += __shfl_xor(q, 1); q += __shfl_xor(q, 2); q += __shfl_xor(q, 4); q += __shfl_xor(q, 8);
        const float rs = rsqrtf(q * (1.0f / 256.0f) + 1e-6f);
        float v[16];
#pragma unroll
        for (int i = 0; i < 16; ++i) v[i] = o[i] * rs * gn[i] * silu(r[i]);
        u32x4 w0, w1;
        w0.x = pk2(v[0], v[1]); w0.y = pk2(v[2], v[3]); w0.z = pk2(v[4], v[5]); w0.w = pk2(v[6], v[7]);
        w1.x = pk2(v[8], v[9]); w1.y = pk2(v[10], v[11]); w1.z = pk2(v[12], v[13]); w1.w = pk2(v[14], v[15]);
        *((u32x4*)(A2 + (size_t)m * DM) + 2 * lane) = w0; *((u32x4*)(A2 + (size_t)m * DM) + 2 * lane + 1) = w1;
    }
}
__device__ __forceinline__ void final_norm(ArgP a, int gw, int NGW, int lane) {
    const bf16_t* __restrict__ XL = (const bf16_t*)(a->ws + OFF_X); const bf16_t* __restrict__ XH = (const bf16_t*)(a->ws + OFF_XB); const float* __restrict__ gfin = a->in[I_NFIN];
#pragma unroll 4
    for (int m = gw; m < MR; m += NGW) {
        float* __restrict__ dst;
        if (m < MP) { const int b = m / LP, t = m - b * LP; if (t < NMETA) continue; dst = a->out + OUT_YP + ((size_t)b * 2048 + (t - NMETA)) * DM; }
        else dst = a->out + OUT_YS + (size_t)(m - MP) * DM;
        f32x4 v[4]; float s = 0.f;
#pragma unroll
        for (int j = 0; j < 4; ++j) { const u32x2 hh = *((const u32x2*)(XH + (size_t)m * DM) + 64 * j + lane), ll = RESID_LO ? *((const u32x2*)(XL + (size_t)m * DM) + 64 * j + lane) : (u32x2){0u, 0u};
            v[j] = (f32x4){blo(hh.x) + blo(ll.x), bhi(hh.x) + bhi(ll.x), blo(hh.y) + blo(ll.y), bhi(hh.y) + bhi(ll.y)}; s += (v[j][0] * v[j][0] + v[j][1] * v[j][1]) + (v[j][2] * v[j][2] + v[j][3] * v[j][3]); }
        const float rs = rsqrtf(wave_sum(s) * (1.0f / 1024.0f) + 1e-6f);
#pragma unroll
        for (int j = 0; j < 4; ++j) { const f32x4 gg = *((const f32x4*)gfin + 64 * j + lane); __builtin_nontemporal_store(v[j] * rs * gg, (f32x4*)dst + 64 * j + lane); }
    }
}

constexpr int PM_SPLIT = 64, ROW_SPLIT = PM_SPLIT * 256;
template <int K>
__device__ __forceinline__ void resid_gemm(const bf16_t* A, const bf16_t* Wt, unsigned char* ws, PG8_LAS unsigned char* ring, int wg, int G, int gw, int NGW, int lane, const XcdBarrier& bar) {
    bf16_t* X = (bf16_t*)(ws + OFF_X); bf16_t* XB = (bf16_t*)(ws + OFF_XB); float* SS = (float*)(ws + OFF_SS);
    {
        pg8::Gemm g{A, Wt, ROW_SPLIT, DM, K, K}; pg8::StaticOrder S; S.init(ROW_SPLIT, DM, G, wg);
        pg8::EpiResid E{X, XB, SS};
        pg8::gemm_phase<pg8::EpiResid, pg8::StaticOrder, true, true>(ring, g, S, E);
#if PROBE_MASK & 4096
        { pg8::EpiProj E2{(bf16_t*)(ws + OFF_O), SS, DM}; pg8::gemm_phase<pg8::EpiProj, pg8::StaticOrder, true, true>(ring, g, S, E2); }
#endif
#if PROBE_MASK & 16384
        { pg8::EpiResidT<true> E2{X, XB, SS}; pg8::gemm_phase<pg8::EpiResidT<true>, pg8::StaticOrder, true, true>(ring, g, S, E2); }
#endif
    }
    {
        int kslice = 256; asm volatile("" : "+s"(kslice));
        pg8::Gemm g{A, Wt, MPAD, DM, kslice, K}; pg8::SplitOrder S{PM_SPLIT, MPAD / 256 - PM_SPLIT, DM / 256, K / 256, 512, G, wg};
        pg8::EpiPart E{(bf16_t*)(ws + OFF_PART), ROW_SPLIT, MPAD - ROW_SPLIT};
        pg8::gemm_phase<pg8::EpiPart, pg8::SplitOrder, true, true>(ring, g, S, E);
#if PROBE_MASK & 8192
        pg8::gemm_phase<pg8::EpiPart, pg8::SplitOrder, true, true>(ring, g, S, E);
#endif
    }
    xcd_barrier(bar);
    constexpr int nks = K / 256;
    const bf16_t* PART = (const bf16_t*)(ws + OFF_PART);
    const int wave_ = gw % NWAVES, wg_ = gw / NWAVES;
    for (int m = ROW_SPLIT + wave_ * G + wg_; m < MPAD; m += NGW) {
        u32x2 hh[4], ll[4], p[4][nks];
#pragma unroll
        for (int j = 0; j < 4; ++j) {
            hh[j] = *((const u32x2*)(XB + (size_t)m * DM) + 64 * j + lane);
            ll[j] = RESID_LO ? *((const u32x2*)(X + (size_t)m * DM) + 64 * j + lane) : (u32x2){0u, 0u};
#pragma unroll
            for (int ks = 0; ks < nks; ++ks) p[j][ks] = *((const u32x2*)(PART + ((size_t)ks * (MPAD - ROW_SPLIT) + (m - ROW_SPLIT)) * DM) + 64 * j + lane);
        }
        float s = 0.f;
#pragma unroll
        for (int j = 0; j < 4; ++j) {
            f32x4 v = {blo(hh[j].x) + blo(ll[j].x), bhi(hh[j].x) + bhi(ll[j].x), blo(hh[j].y) + blo(ll[j].y), bhi(hh[j].y) + bhi(ll[j].y)};
#pragma unroll
            for (int ks = 0; ks < nks; ++ks) v = v + (f32x4){blo(p[j][ks].x), bhi(p[j][ks].x), blo(p[j][ks].y), bhi(p[j][ks].y)};
            u32x2 w; w.x = pk2(v[0], v[1]); w.y = pk2(v[2], v[3]);
            u32x2 wl; wl.x = pk2(v[0] - blo(w.x), v[1] - bhi(w.x)); wl.y = pk2(v[2] - blo(w.y), v[3] - bhi(w.y));
            *((u32x2*)(XB + (size_t)m * DM) + 64 * j + lane) = w;
            if (RESID_LO) *((u32x2*)(X + (size_t)m * DM) + 64 * j + lane) = wl;
            s += (v[0] * v[0] + v[1] * v[1]) + (v[2] * v[2] + v[3] * v[3]);
        }
        s = wave_sum(s);
        if (lane < 16) SS[(size_t)m * 16 + lane] = (lane == 0) ? s : 0.f;
    }
}

__global__ void __launch_bounds__(NTHR, 2) trunk_fwd(Args args) {
    extern __shared__ __attribute__((aligned(16))) unsigned char lds[];
    const int ph_lo = args.ph_lo, ph_hi = args.ph_hi;
    XcdBarrier bar; bar.bar = nullptr; bar.x = 0; bar.st = nullptr;
    if (ph_hi - ph_lo > 1) {
        volatile LAS unsigned* st = (volatile LAS unsigned*)((LAS unsigned char*)lds + LDS_BYTES - 64);
        if (threadIdx.x < 2) st[threadIdx.x] = 0u;
        __syncthreads();
        bar = xcd_barrier_post((unsigned*)(args.ws + 4096), st);
    }
    for (int ph = ph_lo; ph < ph_hi; ++ph) {
#if PROBE_MASK
      for (int rep = 0; rep < 2; ++rep) {
        if (rep == 1) {
            bool again = false;
            if (ph == 0) again = (PROBE_MASK & 1) != 0; else if (ph == NPHASE - 1) again = (PROBE_MASK & 256) != 0;
            else { const int l_ = (ph - 1) / 10, st_ = (ph - 1) % 10; const bool ev_ = (l_ & 1) == 0;
                if (st_ == 3) again = ev_ ? (PROBE_MASK & 2) != 0 : (PROBE_MASK & 8) != 0;
                else if (st_ == 4) again = ev_ ? (PROBE_MASK & 1024) != 0 : (PROBE_MASK & 2048) != 0;
                else if (st_ == 5) again = ev_ ? (PROBE_MASK & 4) != 0 : (PROBE_MASK & 16) != 0;
                else if (st_ == 0 || st_ == 8) again = (PROBE_MASK & 32) != 0;
                else if (st_ == 2) again = (PROBE_MASK & 64) != 0;
                else if (st_ == 6) again = ev_ && (PROBE_MASK & 128) != 0; }
            if (!again) break;
        }
#endif
        const ArgP ap = arg_ptr();
        const int tid = ltid(), lane = tid & 63, wave = __builtin_amdgcn_readfirstlane(tid >> 6);
        const int wg = lwg(), G = lgrid();
        const int gw = wg * NWAVES + wave, NGW = G * NWAVES;
        unsigned char* ws = ap->ws;
        PG8_LAS unsigned char* ring = (PG8_LAS unsigned char*)lds;
        if (ph == 0) {
            phase_prologue(ap, lds, wg, G);
        } else if (ph == NPHASE - 1) {
            final_norm(ap, gw, NGW, lane);
        } else {
            const int l = (ph - 1) / 10, st = (ph - 1) % 10, li = l >> 1; const bool even = (l & 1) == 0;
            if (st == 0 || st == 8) {
                pg8::Gemm g{(const bf16_t*)(ws + OFF_XB), w_gu(ws, l, st == 8), MPAD, NGU, DM, DM}; pg8::StaticOrder S; S.init(MPAD, NGU, G, wg);
                pg8::EpiGU E{(bf16_t*)(ws + OFF_HP), (const float*)(ws + OFF_SS), DFF};
                pg8::gemm_phase<pg8::EpiGU, pg8::StaticOrder, true, true>(ring, g, S, E);
            } else if (st == 1 || st == 9) {
                resid_gemm<DFF>((const bf16_t*)(ws + OFF_HP), w_dn(ws, l, st == 9), ws, ring, wg, G, gw, NGW, lane, bar);
            } else if (st == 2) {
                const int N = even ? NAB : NGLAP;
                pg8::Gemm g{(const bf16_t*)(ws + OFF_XB), even ? w_abin(ws, li) : w_gin(ws, li), MPAD, N, DM, DM}; pg8::StaticOrder S; S.init(MPAD, N, G, wg);
                pg8::EpiProj E{(bf16_t*)(ws + OFF_HP), (const float*)(ws + OFF_SS), N};
                pg8::gemm_phase<pg8::EpiProj, pg8::StaticOrder, true, true>(ring, g, S, E);
            } else if (st == 3) {
                if (even) { la_prep<64, false>(ap, li, lds, wg, G); __syncthreads(); s5_pass1(ap, li, lds, gw, NGW, lane, wave); }
                else la_prep<128, true>(ap, li, lds, wg, G);
            } else if (st == 4) {
                if (even) { la_prompt<64, 128, 16, false>(ap, li, lds, wg, G); la_sample<64, 128, false>(ap, li, lds, wg, G); __syncthreads(); s5_pass2(ap, li, lds, gw, NGW, lane, wave); }
                else { la_prompt<128, 256, 32, true>(ap, li, lds, wg, G); la_sample<128, 256, true>(ap, li, lds, wg, G); }
            } else if (st == 5) {
                if (even) {
                    pg8::Gemm g{(const bf16_t*)(ws + OFF_Z), w_glu(ws, li), MPAD, 512, 512, 512}; pg8::StaticOrder S; S.init(MPAD, 512, G, wg);
                    pg8::EpiGlu E{(const bf16_t*)(ws + OFF_Z), (bf16_t*)(ws + OFF_A2)};
                    pg8::gemm_phase<pg8::EpiGlu, pg8::StaticOrder, true, true>(ring, g, S, E);
                    ret_finalize(ap, gw, NGW, lane);
                }
                else gla_finalize(ap, li, gw, NGW, lane);
            } else if (st == 6) {
            } else {
                resid_gemm<DM>((const bf16_t*)(ws + OFF_A2), even ? w_about(ws, li) : w_gout(ws, li), ws, ring, wg, G, gw, NGW, lane, bar);
            }
        }
#if PROBE_MASK
      }
#endif
        const bool empty_slot = (ph >= 1 && ph < NPHASE - 1 && ((ph - 1) % 10) == 6);
        if (ph + 1 < ph_hi && !empty_slot) {
            if (ph_hi < 0) { __threadfence(); cg::this_grid().sync(); }
            { xcd_barrier(bar); if (PROBE_MASK & 512) { xcd_barrier(bar); xcd_barrier(bar); } }
        }
    }
}

#ifndef N_LAUNCH_MODE
#define N_LAUNCH_MODE 1
#endif
extern "C" void kernel_launch(void* const* d_in, const int* in_sizes, int n_in, void* d_out, int out_size, void* d_ws, size_t ws_size, hipStream_t stream) {
    static int grid = 0;
    if (grid == 0) {
        if (n_in != N_IN || (size_t)out_size != OUT_END || ws_size < WS_END) { fprintf(stderr, "kernel_launch: unexpected sizes n_in %d out %d ws %zu (need %zu)\n", n_in, out_size, ws_size, (size_t)WS_END); grid = -1; return; }
        int dev = 0, cus = 0, per_cu = 0;
        (void)hipGetDevice(&dev); (void)hipDeviceGetAttribute(&cus, hipDeviceAttributeMultiprocessorCount, dev);
        if (hipFuncSetAttribute((const void*)trunk_fwd, hipFuncAttributeMaxDynamicSharedMemorySize, LDS_BYTES) != hipSuccess) { fprintf(stderr, "kernel_launch: hipFuncSetAttribute failed\n"); grid = -1; return; }
        if (hipOccupancyMaxActiveBlocksPerMultiprocessor(&per_cu, (const void*)trunk_fwd, NTHR, LDS_BYTES) != hipSuccess || per_cu < 1) { fprintf(stderr, "kernel_launch: occupancy query says %d\n", per_cu); per_cu = 1; }
        (void)hipGetLastError();
        grid = cus * 1;
        if (grid <= 0) grid = 256;
    }
    if (grid < 0) return;
    Args a{};
    for (int i = 0; i < N_IN; ++i) a.in[i] = (const float*)d_in[i];
    a.out = (float*)d_out; a.ws = (unsigned char*)d_ws;
#if N_LAUNCH_MODE == 1
    if (hipMemsetAsync(d_ws, 0, 65536, stream) != hipSuccess) { fprintf(stderr, "kernel_launch: memset failed\n"); return; }
    a.ph_lo = 0; a.ph_hi = NPHASE;
    void* kargs[] = {&a};
    hipError_t e = hipLaunchCooperativeKernel((const void*)trunk_fwd, dim3(grid), dim3(NTHR), kargs, LDS_BYTES, stream);
    if (e != hipSuccess) fprintf(stderr, "kernel_launch: cooperative launch failed: %s (grid %d)\n", hipGetErrorString(e), grid);
#else
    for (int ph = 0; ph < NPHASE; ++ph) {
        if (ph >= 1 && ph < NPHASE - 1 && ((ph - 1) % 10) == 6 && (((ph - 1) / 10) & 1)) continue;
        a.ph_lo = ph; a.ph_hi = ph + 1;
        hipLaunchKernelGGL(trunk_fwd, dim3(grid), dim3(NTHR), LDS_BYTES, stream, a);
    }
#endif
}
```
